# Optimizing an MI355X kernel written in HIP

```python
import jax, jax.numpy as jnp
from jax import lax
import numpy as np

D_MODEL = 1024
BATCH = 2
SEQ = 8192
DEPTH = 1

MLA_HEADS = 8
MLA_Q_RANK = 256
MLA_KV_RANK = 128
MLA_NOPE_DIM = 64
MLA_ROPE_DIM = 32
MLA_V_DIM = 64
MLA_QK_DIM = MLA_NOPE_DIM + MLA_ROPE_DIM
Q_BLOCK = 128
RET_HEADS = 8
RET_QK_DIM = D_MODEL // (2 * RET_HEADS)
RET_V_DIM = 2 * RET_QK_DIM
RET_CHUNK = 128
FFN_HIDDEN = -(-8 * D_MODEL // (3 * 256)) * 256
ROPE_THETA = 10000.0
EPS = 1e-6

IN_SPLITS = [
    MLA_Q_RANK,
    MLA_KV_RANK,
    MLA_ROPE_DIM,
    RET_HEADS * RET_QK_DIM,
    RET_HEADS * RET_QK_DIM,
    RET_HEADS * RET_V_DIM,
    RET_HEADS * RET_V_DIM,
    2 * D_MODEL,
]
IN_WIDTH = sum(IN_SPLITS)

kernel_name = "hybrid_mla_retention_gated_block"


def _rms(xf):
    return xf * lax.rsqrt(jnp.mean(xf * xf, axis=-1, keepdims=True) + EPS)


def rms_norm(x, g):
    y = _rms(x.astype(jnp.float32)) * g.astype(jnp.float32)
    return y.astype(x.dtype)


def rope(x, positions):
    half = x.shape[-1] // 2
    inv = ROPE_THETA ** (-jnp.arange(half, dtype=jnp.float32) / half)
    ang = positions.astype(jnp.float32)[..., None] * inv
    cos = jnp.cos(ang)[:, :, None, :]
    sin = jnp.sin(ang)[:, :, None, :]
    xf = x.astype(jnp.float32)
    x1, x2 = xf[..., :half], xf[..., half:]
    out = jnp.concatenate([x1 * cos - x2 * sin, x2 * cos + x1 * sin], axis=-1)
    return out.astype(x.dtype)


def mla_attention(c_q, c_kv, k_rope, positions, g_q_a, w_q_b, g_kv_a, w_kv_b, g_qn, g_kn):
    B, S, _ = c_q.shape
    H = MLA_HEADS
    q = (rms_norm(c_q, g_q_a) @ w_q_b).reshape(B, S, H, MLA_QK_DIM)
    kv = (rms_norm(c_kv, g_kv_a) @ w_kv_b).reshape(B, S, H, MLA_NOPE_DIM + MLA_V_DIM)
    k_nope, v = kv[..., :MLA_NOPE_DIM], kv[..., MLA_NOPE_DIM:]
    k_r = jnp.broadcast_to(k_rope[:, :, None, :], (B, S, H, MLA_ROPE_DIM))
    k = jnp.concatenate([k_nope, k_r], axis=-1)
    q = rms_norm(q, g_qn)
    k = rms_norm(k, g_kn)
    q = jnp.concatenate([q[..., :MLA_NOPE_DIM], rope(q[..., MLA_NOPE_DIM:], positions)], axis=-1)
    k = jnp.concatenate([k[..., :MLA_NOPE_DIM], rope(k[..., MLA_NOPE_DIM:], positions)], axis=-1)
    q = q.astype(jnp.float32).transpose(0, 2, 1, 3)
    k = k.astype(jnp.float32).transpose(0, 2, 1, 3)
    v = v.astype(jnp.float32).transpose(0, 2, 1, 3)
    scale = MLA_QK_DIM ** -0.5
    nb = S // Q_BLOCK
    qb = q.reshape(B, H, nb, Q_BLOCK, MLA_QK_DIM).transpose(2, 0, 1, 3, 4)

    def attend(q_blk):
        s = jnp.einsum('bhqd,bhkd->bhqk', q_blk, k) * scale
        p = jax.nn.softmax(s, axis=-1)
        return jnp.einsum('bhqk,bhkv->bhqv', p, v)

    o = lax.map(attend, qb)
    o = o.transpose(1, 0, 3, 2, 4).reshape(B, S, H * MLA_V_DIM)
    return o


def retention_dir(q, k, v, log_gamma, strict):
    B, H, S, dk = q.shape
    dv = v.shape[-1]
    C = RET_CHUNK
    n = S // C
    idx = jnp.arange(C, dtype=jnp.float32)
    diff = idx[:, None] - idx[None, :]
    mask = diff > 0 if strict else diff >= 0
    decay_in = jnp.where(mask, jnp.exp(log_gamma[:, None, None] * jnp.maximum(diff, 0.0)), 0.0)
    q_decay = jnp.exp(log_gamma[:, None] * (idx + 1.0))[..., None]
    k_decay = jnp.exp(log_gamma[:, None] * (C - 1.0 - idx))[..., None]
    chunk_decay = jnp.exp(log_gamma * C)[:, None, None]

    def to_chunks(a):
        return a.reshape(B, H, n, C, a.shape[-1]).transpose(2, 0, 1, 3, 4)

    def step(state, inp):
        qi, ki, vi = inp
        inner = jnp.einsum('bhcd,bhed->bhce', qi, ki) * decay_in
        inner = jnp.einsum('bhce,bhev->bhcv', inner, vi)
        cross = jnp.einsum('bhcd,bhdv->bhcv', qi * q_decay, state)
        new_state = state * chunk_decay + jnp.einsum('bhcd,bhcv->bhdv', ki * k_decay, vi)
        return new_state, inner + cross

    state0 = jnp.zeros((B, H, dk, dv), jnp.float32)
    _, out = lax.scan(step, state0, (to_chunks(q), to_chunks(k), to_chunks(v)))
    return out.transpose(1, 2, 0, 3, 4).reshape(B, H, S, dv)


def bidirectional_retention(q, k, v, decay_fwd, decay_bwd):
    lg_f = -jnp.exp(decay_fwd.astype(jnp.float32))
    lg_b = -jnp.exp(decay_bwd.astype(jnp.float32))
    fwd = retention_dir(q, k, v, lg_f, False)
    flip = lambda a: jnp.flip(a, axis=2)
    bwd = flip(retention_dir(flip(q), flip(k), flip(v), lg_b, True))
    return fwd + bwd


def setup_inputs(seed: int = 0) -> dict:
    key = jax.random.key(seed)
    ks = jax.random.split(key, 20)
    f32 = jnp.float32

    def w(k, fan_in, fan_out):
        return jax.random.normal(k, (fan_in, fan_out), f32) * fan_in ** -0.5

    def gain(k, n):
        return 1.0 + 0.02 * jax.random.normal(k, (n,), f32)

    gamma0 = 1.0 - 2.0 ** (-5.0 - jnp.arange(RET_HEADS, dtype=f32))
    decay_base = jnp.log(-jnp.log(gamma0))
    x = jax.random.normal(ks[0], (BATCH, SEQ, D_MODEL), f32)
    positions = (jnp.arange(SEQ, dtype=jnp.int32)[None, :]
                 + jax.random.randint(ks[1], (BATCH, 1), 0, SEQ, dtype=jnp.int32))
    return {
        "x": x,
        "positions": positions,
        "g_mix": gain(ks[2], D_MODEL),
        "w_in": w(ks[3], D_MODEL, IN_WIDTH),
        "g_q_a": gain(ks[4], MLA_Q_RANK),
        "w_q_b": w(ks[5], MLA_Q_RANK, MLA_HEADS * MLA_QK_DIM),
        "g_kv_a": gain(ks[6], MLA_KV_RANK),
        "w_kv_b": w(ks[7], MLA_KV_RANK, MLA_HEADS * (MLA_NOPE_DIM + MLA_V_DIM)),
        "g_qn": gain(ks[8], MLA_QK_DIM),
        "g_kn": gain(ks[9], MLA_QK_DIM),
        "w_mla_out": w(ks[10], MLA_HEADS * MLA_V_DIM, D_MODEL),
        "ret_decay_fwd": decay_base + 0.05 * jax.random.normal(ks[11], (RET_HEADS,), f32),
        "ret_decay_bwd": decay_base + 0.05 * jax.random.normal(ks[12], (RET_HEADS,), f32),
        "w_ret_out": w(ks[13], RET_HEADS * RET_V_DIM, D_MODEL),
        "w_out": w(ks[14], D_MODEL, D_MODEL),
        "g_ffn": gain(ks[15], D_MODEL),
        "w_gate_up": w(ks[16], D_MODEL, 2 * FFN_HIDDEN),
        "w_down": w(ks[17], FFN_HIDDEN, D_MODEL),
    }


def reference(x, positions, g_mix, w_in, g_q_a, w_q_b, g_kv_a, w_kv_b, g_qn, g_kn,
              w_mla_out, ret_decay_fwd, ret_decay_bwd, w_ret_out, w_out,
              g_ffn, w_gate_up, w_down):
    B, S, D = x.shape
    split_idx = np.cumsum(IN_SPLITS)[:-1].tolist()
    for _ in range(DEPTH):
        h = rms_norm(x, g_mix)
        proj = h @ w_in
        c_q, c_kv, k_rope, q_r, k_r, v_r, g_r, gate_logits = jnp.split(proj, split_idx, axis=-1)

        o_a = mla_attention(c_q, c_kv, k_rope, positions, g_q_a, w_q_b, g_kv_a, w_kv_b, g_qn, g_kn)
        y_a = o_a.astype(x.dtype) @ w_mla_out

        q_r = rope(q_r.reshape(B, S, RET_HEADS, RET_QK_DIM), positions)
        k_r = rope(k_r.reshape(B, S, RET_HEADS, RET_QK_DIM), positions)
        q_r = q_r.astype(jnp.float32).transpose(0, 2, 1, 3)
        k_r = k_r.astype(jnp.float32).transpose(0, 2, 1, 3) * (RET_QK_DIM ** -0.5)
        v_r = v_r.reshape(B, S, RET_HEADS, RET_V_DIM).astype(jnp.float32).transpose(0, 2, 1, 3)
        ret = bidirectional_retention(q_r, k_r, v_r, ret_decay_fwd, ret_decay_bwd)
        ret = _rms(ret).transpose(0, 2, 1, 3).reshape(B, S, RET_HEADS * RET_V_DIM)
        o_b = (jax.nn.silu(g_r.astype(jnp.float32)) * ret).astype(x.dtype)
        y_b = o_b @ w_ret_out

        gates = jax.nn.sigmoid(gate_logits.astype(jnp.float32))
        merged = gates[..., :D] * y_a.astype(jnp.float32) + gates[..., D:] * y_b.astype(jnp.float32)
        x = x + merged.astype(x.dtype) @ w_out

        h2 = rms_norm(x, g_ffn)
        gu = h2 @ w_gate_up
        gate, up = gu[..., :FFN_HIDDEN], gu[..., FFN_HIDDEN:]
        x = x + (jax.nn.silu(gate) * up) @ w_down
    return x
```

```cpp
#include <hip/hip_runtime.h>
#include <hip/hip_cooperative_groups.h>
#include <cstdio>
#include <cstdint>
namespace cg = cooperative_groups;
#include <cstddef>
constexpr size_t MiB = 1u << 20;
constexpr size_t WS_WIN = 0, WS_WGU = 11 * MiB, WS_WDN = 22 * MiB, WS_WRET = 27 * MiB + 512 * 1024, WS_WOUT = 29 * MiB + 512 * 1024, WS_WMLA = 31 * MiB + 512 * 1024,
                 WS_WQB = 32 * MiB + 512 * 1024, WS_WKVB = 33 * MiB;
constexpr size_t WS_COSR = 34 * MiB, WS_SINR = 36 * MiB, WS_COSA = 38 * MiB, WS_SINA = 39 * MiB, WS_SSQP = 40 * MiB;
constexpr size_t WS_XN = 41 * MiB;
constexpr size_t WS_CQ = 73 * MiB, WS_CKV = 81 * MiB, WS_KROPE = 85 * MiB, WS_UQ = 86 * MiB, WS_UKV = 110 * MiB, WS_AQ = 142 * MiB, WS_AK = 166 * MiB, WS_AV = 190 * MiB, WS_AO = 206 * MiB;
constexpr size_t WS_RQ = 73 * MiB, WS_RK = 89 * MiB, WS_VR = 105 * MiB, WS_GR = 222 * MiB, WS_LT = 169 * MiB, WS_OB = 137 * MiB;
constexpr size_t WS_YB = 73 * MiB, WS_YA = 169 * MiB, WS_MERGED = 222 * MiB, WS_X1B = 73 * MiB, WS_HID = 105 * MiB;
constexpr int VT_PITCH = 16384 + 64;
constexpr size_t WS_RSTD = 254 * MiB + 16384;
constexpr size_t WS_BAR = 254 * MiB;
constexpr size_t WS_END = 254 * MiB + 16384 + 65536;

namespace pg8 {
#define PG8_LAS __attribute__((address_space(3)))
typedef unsigned short bf16_t;
typedef short bf16x8 __attribute__((ext_vector_type(8)));
typedef float f32x4 __attribute__((ext_vector_type(4)));
typedef unsigned u32x4 __attribute__((ext_vector_type(4)));
constexpr int BM = 256, BK = 64, HALF = 128, HTB = HALF * BK * 2  , STAGE_BYTES = 8 * HTB, NXCD = 8, WGM = 4;

__host__ __device__ __forceinline__ int lds_byte(int r, int c) { const int st = (r >> 4) * 2 + (c >> 5), rr = r & 15, cc = c & 31, ob = rr * 64 + cc * 2; return st * 1024 + (ob ^ (((ob >> 9) & 1) << 5)); }
__host__ __device__ __forceinline__ void stage_rc(int b, int& R, int& C) { const int st = b / 1024, sb = b % 1024, swz = sb ^ (((sb >> 9) & 1) << 5); R = (st >> 1) * 16 + swz / 64; C = (st & 1) * 32 + (swz % 64) / 2; }
__host__ __device__ __forceinline__ int perm32(int rho) { const int n = rho >> 4, i = rho & 15; return 8 * (i >> 2) + 4 * n + (i & 3); }

struct Unit { int pm, pn; };
struct Gemm { const bf16_t* A; const bf16_t* Bt; int M, N, K; };

struct StaticOrder {
    int nM, nN, nwg, G, c;
    __host__ __device__ void init(int M, int N, int G_, int c_) { nM = M / BM; nN = N / BM; nwg = nM * nN; G = G_; c = c_; }
    __host__ __device__ bool next(int i, Unit& u) const {
        const long L = (long)i * G + c; if (L >= nwg) return false;
        int wgid = (int)L; { const int q = nwg / NXCD, r = nwg % NXCD, xcd = wgid % NXCD, off = wgid / NXCD; wgid = (xcd < r ? xcd * (q + 1) : r * (q + 1) + (xcd - r) * q) + off; }
        const int nig = WGM * nN, gid = wgid / nig, fm = gid * WGM, gsz = (nM - fm) < WGM ? (nM - fm) : WGM;
        u.pm = fm + ((wgid % nig) % gsz); u.pn = (wgid % nig) / gsz; return true;
    }
    __device__ __forceinline__ void a_ready(const Unit&) const {}
    __device__ __forceinline__ void done(const Unit&) const {}
};

__device__ __forceinline__ unsigned cvt_pk_bf16(float lo, float hi) { unsigned r; asm volatile("v_cvt_pk_bf16_f32 %0, %1, %2" : "=v"(r) : "v"(lo), "v"(hi)); return r; }
typedef float f32x2 __attribute__((ext_vector_type(2)));
typedef unsigned u32x2 __attribute__((ext_vector_type(2)));
typedef float f32x2 __attribute__((ext_vector_type(2)));
typedef __bf16 bf16x2_t __attribute__((ext_vector_type(2)));
__device__ __forceinline__ unsigned pkbf(float lo, float hi) { f32x2 v = {lo, hi}; bf16x2_t b = __builtin_convertvector(v, bf16x2_t); return __builtin_bit_cast(unsigned, b); }
__device__ __forceinline__ float bf_lo(unsigned w) { return __uint_as_float(w << 16); }
__device__ __forceinline__ float bf_hi(unsigned w) { return __uint_as_float(w & 0xffff0000u); }
__device__ __forceinline__ float sigm(float x) { return __builtin_amdgcn_rcpf(1.f + __expf(-x)); }
__device__ __forceinline__ u32x4 pk8(const f32x4 a, const f32x4 b) { u32x4 w; w.x = pkbf(a[0], a[1]); w.y = pkbf(a[2], a[3]); w.z = pkbf(b[0], b[1]); w.w = pkbf(b[2], b[3]); return w; }

template <int X> __device__ __forceinline__ float shx(float v) { return __int_as_float(__builtin_amdgcn_ds_swizzle(__float_as_int(v), (X << 10) | 0x1f)); }
__device__ __forceinline__ float add_x32(float v) { auto rr = __builtin_amdgcn_permlane32_swap(__float_as_uint(v), __float_as_uint(v), false, false); return __uint_as_float(rr[0]) + __uint_as_float(rr[1]); }
__device__ __forceinline__ float max_x32(float v) { auto rr = __builtin_amdgcn_permlane32_swap(__float_as_uint(v), __float_as_uint(v), false, false); return fmaxf(__uint_as_float(rr[0]), __uint_as_float(rr[1])); }

struct EpiProj {
    static constexpr bool PERM = true, AFTER_DRAIN = false;
    int t0; unsigned char* ws;
    __device__ __forceinline__ void operator()(const f32x4 (&acc)[2][2][4][2], const Unit& u, int wr, int wc, int fr, int fq) const {
        const int t = t0 + u.pn;
        const int row0 = u.pm * BM + wr * 64 + fr;
        if (t >= 2 && t < 6) {
            const bool isk = t >= 4; bf16_t* O = (bf16_t*)(ws + (isk ? WS_RK : WS_RQ)); const float sc = isk ? 0.125f : 1.f;
            const float* cosR = (const float*)(ws + WS_COSR); const float* sinR = (const float*)(ws + WS_SINR);
            const int head = 4 * (t & 1) + wc, dl0 = 8 * fq;
#pragma unroll
            for (int ai = 0; ai < 2; ++ai)
#pragma unroll
              for (int mp = 0; mp < 2; ++mp) {
                f32x4 cc[2][2], sn_[2][2];
#pragma unroll
                for (int mm = 0; mm < 2; ++mm) { const size_t ro = (size_t)(row0 + ai * HALF + (2 * mp + mm) * 16) * 32 + dl0;
                    cc[mm][0] = *(const f32x4*)(cosR + ro); cc[mm][1] = *(const f32x4*)(cosR + ro + 4); sn_[mm][0] = *(const f32x4*)(sinR + ro); sn_[mm][1] = *(const f32x4*)(sinR + ro + 4); }
#pragma unroll
                for (int mm = 0; mm < 2; ++mm) {
                    const int m = 2 * mp + mm;
                    const int row = row0 + ai * HALF + m * 16;
                    const f32x4 c0 = cc[mm][0], c1 = cc[mm][1], s0 = sn_[mm][0], s1 = sn_[mm][1];
                    const f32x4 x1a = acc[ai][0][m][0], x1b = acc[ai][0][m][1], x2a = acc[ai][1][m][0], x2b = acc[ai][1][m][1];
                    const f32x4 o1a = (x1a * c0 - x2a * s0) * sc, o1b = (x1b * c1 - x2b * s1) * sc;
                    const f32x4 o2a = (x2a * c0 + x1a * s0) * sc, o2b = (x2b * c1 + x1b * s1) * sc;
                    bf16_t* p = O + (size_t)row * 512 + head * 64 + dl0;
                    *(u32x4*)p = pk8(o1a, o1b); *(u32x4*)(p + 32) = pk8(o2a, o2b);
                }
                asm volatile("" ::: "memory");
              }
        } else if (t >= 14) {
            const bf16_t* YA = (const bf16_t*)(ws + WS_YA); const bf16_t* YB = (const bf16_t*)(ws + WS_YB); bf16_t* MG = (bf16_t*)(ws + WS_MERGED);
            const int col = 128 * (t - 14) + 32 * wc + 8 * fq;
#pragma unroll
            for (int ai = 0; ai < 2; ++ai) {
                u32x4 yav[4], ybv[4];
#pragma unroll
                for (int m = 0; m < 4; ++m) { const size_t off = (size_t)(row0 + ai * HALF + m * 16) * 1024 + col; yav[m] = *(const u32x4*)(YA + off); ybv[m] = *(const u32x4*)(YB + off); }
#pragma unroll
                for (int m = 0; m < 4; ++m) {
                    const size_t off = (size_t)(row0 + ai * HALF + m * 16) * 1024 + col;
                    const u32x4 ya = yav[m], yb = ybv[m];
                    const f32x4 la0 = acc[ai][0][m][0], la1 = acc[ai][0][m][1], lb0 = acc[ai][1][m][0], lb1 = acc[ai][1][m][1];
                    f32x4 r0, r1;
                    r0[0] = sigm(la0[0]) * bf_lo(ya.x) + sigm(lb0[0]) * bf_lo(yb.x); r0[1] = sigm(la0[1]) * bf_hi(ya.x) + sigm(lb0[1]) * bf_hi(yb.x);
                    r0[2] = sigm(la0[2]) * bf_lo(ya.y) + sigm(lb0[2]) * bf_lo(yb.y); r0[3] = sigm(la0[3]) * bf_hi(ya.y) + sigm(lb0[3]) * bf_hi(yb.y);
                    r1[0] = sigm(la1[0]) * bf_lo(ya.z) + sigm(lb1[0]) * bf_lo(yb.z); r1[1] = sigm(la1[1]) * bf_hi(ya.z) + sigm(lb1[1]) * bf_hi(yb.z);
                    r1[2] = sigm(la1[2]) * bf_lo(ya.w) + sigm(lb1[2]) * bf_lo(yb.w); r1[3] = sigm(la1[3]) * bf_hi(ya.w) + sigm(lb1[3]) * bf_hi(yb.w);
                    *(u32x4*)(MG + off) = pk8(r0, r1);
                }
                asm volatile("" ::: "memory");
            }
        } else {
#pragma unroll
            for (int bj = 0; bj < 2; ++bj) {
                size_t wo; int ld, col; bool on = true;
                if (t == 0) { wo = WS_CQ; ld = 256; col = 128 * bj; }
                else if (t == 1) { if (bj == 0) { wo = WS_CKV; ld = 128; col = 0; } else { wo = WS_KROPE; ld = 32; col = 0; on = (wc == 0); } }
                else if (t < 10) { wo = WS_VR; ld = 1024; col = 256 * (t - 6) + 128 * bj; }
                else if (t < 14) { wo = WS_GR; ld = 1024; col = 256 * (t - 10) + 128 * bj; }
                else { wo = WS_GR; ld = 1024; col = 256 * ((t - 10) & 3) + 128 * bj; }
                bf16_t* O = (bf16_t*)(ws + wo);
                col += 32 * wc + 8 * fq;
                if (on) {
#pragma unroll
                    for (int ai = 0; ai < 2; ++ai)
#pragma unroll
                        for (int m = 0; m < 4; ++m) {
                            const int row = row0 + ai * HALF + m * 16;
                            *(u32x4*)(O + (size_t)row * ld + col) = pk8(acc[ai][bj][m][0], acc[ai][bj][m][1]);
                        }
                }
            }
        }
    }
};
struct EpiBf16S {
    static constexpr bool PERM = true, AFTER_DRAIN = false;
    bf16_t* O; int ldc;
    __device__ __forceinline__ void operator()(const f32x4 (&acc)[2][2][4][2], const Unit& u, int wr, int wc, int fr, int fq) const {
        const int row0 = u.pm * BM + wr * 64 + fr, col0 = u.pn * BM + 32 * wc + 8 * fq;
#pragma unroll
        for (int ai = 0; ai < 2; ++ai)
#pragma unroll
            for (int m = 0; m < 4; ++m)
#pragma unroll
                for (int bj = 0; bj < 2; ++bj)
                    *(u32x4*)(O + (size_t)(row0 + ai * HALF + m * 16) * ldc + col0 + bj * HALF) = pk8(acc[ai][bj][m][0], acc[ai][bj][m][1]);
    }
};
struct EpiGate {
    static constexpr bool PERM = true, AFTER_DRAIN = false;
    const bf16_t* GL; bf16_t* PART; bf16_t* MERGED; int second;
    __device__ __forceinline__ void operator()(const f32x4 (&acc)[2][2][4][2], const Unit& u, int wr, int wc, int fr, int fq) const {
        const int row0 = u.pm * BM + wr * 64 + fr, col0 = u.pn * BM + 32 * wc + 8 * fq;
#pragma unroll
        for (int ai = 0; ai < 2; ++ai)
#pragma unroll
            for (int m = 0; m < 4; ++m)
#pragma unroll
                for (int bj = 0; bj < 2; ++bj) {
                    const int row = row0 + ai * HALF + m * 16, col = col0 + bj * HALF;
                    const u32x4 g = *(const u32x4*)(GL + (size_t)row * 2048 + second * 1024 + col);
                    const f32x4 a = acc[ai][bj][m][0], b = acc[ai][bj][m][1];
                    f32x4 ra, rb;
                    ra[0] = sigm(bf_lo(g.x)) * a[0]; ra[1] = sigm(bf_hi(g.x)) * a[1]; ra[2] = sigm(bf_lo(g.y)) * a[2]; ra[3] = sigm(bf_hi(g.y)) * a[3];
                    rb[0] = sigm(bf_lo(g.z)) * b[0]; rb[1] = sigm(bf_hi(g.z)) * b[1]; rb[2] = sigm(bf_lo(g.w)) * b[2]; rb[3] = sigm(bf_hi(g.w)) * b[3];
                    if (second) {
                        const u32x4 p = *(const u32x4*)(PART + (size_t)row * 1024 + col);
                        ra[0] += bf_lo(p.x); ra[1] += bf_hi(p.x); ra[2] += bf_lo(p.y); ra[3] += bf_hi(p.y);
                        rb[0] += bf_lo(p.z); rb[1] += bf_hi(p.z); rb[2] += bf_lo(p.w); rb[3] += bf_hi(p.w);
                        *(u32x4*)(MERGED + (size_t)row * 1024 + col) = pk8(ra, rb);
                    } else {
                        *(u32x4*)(PART + (size_t)row * 1024 + col) = pk8(ra, rb);
                    }
                    asm volatile("" ::: "memory");
                }
    }
};
struct EpiWout {
    static constexpr bool PERM = false, AFTER_DRAIN = false;
    const float* X; float* X1; bf16_t* X1B; float* SSQP;
    __device__ __forceinline__ void operator()(const f32x4 (&acc)[2][2][4][2], const Unit& u, int wr, int wc, int fr, int fq) const {
        const int row0 = u.pm * BM + wr * 64 + fr, col0 = u.pn * BM + 32 * wc + 4 * fq;
#pragma unroll
        for (int ai = 0; ai < 2; ++ai)
#pragma unroll
            for (int mp = 0; mp < 2; ++mp) {
                f32x4 xv[2][2][2];
#pragma unroll
                for (int mm = 0; mm < 2; ++mm)
#pragma unroll
                    for (int bj = 0; bj < 2; ++bj)
#pragma unroll
                        for (int n = 0; n < 2; ++n) xv[mm][bj][n] = __builtin_nontemporal_load((const f32x4*)(X + (size_t)(row0 + ai * HALF + (2 * mp + mm) * 16) * 1024 + col0 + bj * HALF + n * 16));
#pragma unroll
                for (int mm = 0; mm < 2; ++mm) {
                    const int m = 2 * mp + mm, row = row0 + ai * HALF + m * 16; float ss = 0.f;
#pragma unroll
                    for (int bj = 0; bj < 2; ++bj)
#pragma unroll
                        for (int n = 0; n < 2; ++n) {
                            const size_t off = (size_t)row * 1024 + col0 + bj * HALF + n * 16;
                            const f32x4 o = xv[mm][bj][n] + acc[ai][bj][m][n];
                            u32x2 w; w.x = pkbf(o[0], o[1]); w.y = pkbf(o[2], o[3]); *(u32x2*)(X1B + off) = w;
                            ss += (o[0] * o[0] + o[1] * o[1]) + (o[2] * o[2] + o[3] * o[3]);
                        }
                    ss += shx<16>(ss); ss = add_x32(ss);
                    if (fq == 0) SSQP[(size_t)row * 16 + 4 * u.pn + wc] = ss;
                }
                asm volatile("" ::: "memory");
            }
    }
};
struct EpiGU {
    static constexpr bool PERM = true, AFTER_DRAIN = false;
    const float* SSQP; bf16_t* HID;
    __device__ __forceinline__ void operator()(const f32x4 (&acc)[2][2][4][2], const Unit& u, int wr, int wc, int fr, int fq) const {
        const int row0 = u.pm * BM + wr * 64 + fr, col0 = u.pn * HALF + 32 * wc + 8 * fq;
#pragma unroll
        for (int ai = 0; ai < 2; ++ai)
#pragma unroll
            for (int m = 0; m < 4; ++m) {
                const int row = row0 + ai * HALF + m * 16;
                const f32x4* sp = (const f32x4*)(SSQP + (size_t)row * 16);
                const f32x4 q0 = sp[0], q1 = sp[1], q2 = sp[2], q3 = sp[3];
                const f32x4 qs = (q0 + q1) + (q2 + q3);
                const float rstd = rsqrtf(((qs[0] + qs[1]) + (qs[2] + qs[3])) * (1.0f / 1024.0f) + 1e-6f);
                f32x4 h[2];
#pragma unroll
                for (int n = 0; n < 2; ++n)
#pragma unroll
                    for (int e = 0; e < 4; ++e) { const float g = acc[ai][0][m][n][e] * rstd, up = acc[ai][1][m][n][e] * rstd; h[n][e] = g * sigm(g) * up; }
                __builtin_nontemporal_store(pk8(h[0], h[1]), (u32x4*)(HID + (size_t)row * 2816 + col0));
                asm volatile("" ::: "memory");
            }
    }
};
struct EpiDown {
    static constexpr bool PERM = false, AFTER_DRAIN = false;
    const bf16_t* X1B; float* OUT;
    __device__ __forceinline__ void operator()(const f32x4 (&acc)[2][2][4][2], const Unit& u, int wr, int wc, int fr, int fq) const {
        const int row0 = u.pm * BM + wr * 64 + fr, col0 = u.pn * BM + 32 * wc + 4 * fq;
#pragma unroll
        for (int ai = 0; ai < 2; ++ai) {
            u32x2 xb[4][2][2];
#pragma unroll
            for (int m = 0; m < 4; ++m)
#pragma unroll
                for (int bj = 0; bj < 2; ++bj)
#pragma unroll
                    for (int n = 0; n < 2; ++n) xb[m][bj][n] = *(const u32x2*)(X1B + (size_t)(row0 + ai * HALF + m * 16) * 1024 + col0 + bj * HALF + n * 16);
#pragma unroll
            for (int m = 0; m < 4; ++m)
#pragma unroll
                for (int bj = 0; bj < 2; ++bj)
#pragma unroll
                    for (int n = 0; n < 2; ++n) {
                        const size_t off = (size_t)(row0 + ai * HALF + m * 16) * 1024 + col0 + bj * HALF + n * 16;
                        f32x4 xv; xv[0] = bf_lo(xb[m][bj][n].x); xv[1] = bf_hi(xb[m][bj][n].x); xv[2] = bf_lo(xb[m][bj][n].y); xv[3] = bf_hi(xb[m][bj][n].y);
                        __builtin_nontemporal_store(xv + acc[ai][bj][m][n], (f32x4*)(OUT + off));
                    }
            asm volatile("" ::: "memory");
        }
    }
};
template <class Epi, class Sched, bool ALIGN_EPI = false, bool SP2 = false>
__device__ __forceinline__ void gemm_phase(PG8_LAS unsigned char* lds, const Gemm g, const Sched& S, const Epi& E, int tid_in) {
    int tid_ = tid_in; asm volatile("" : "+v"(tid_));
    const int tid = tid_, wid = __builtin_amdgcn_readfirstlane(tid >> 6), lane = tid & 63, wr = wid >> 2, wc = wid & 3, fr = lane & 15, fq = lane >> 4;
    const int K = g.K, nt = K / BK;
    unsigned voffA[2], voffB[2];
#pragma unroll
    for (int i = 0; i < 2; ++i) { int R, C; stage_rc(tid * 16 + i * 8192, R, C); const int Rb = Epi::PERM ? ((R & ~31) + perm32(R & 31)) : R;
        voffA[i] = (unsigned)(R * K + C) * 2u; voffB[i] = (unsigned)(Rb * K + C) * 2u; }
    const size_t kstep = (size_t)(BK * 2);
    const size_t hstep = (size_t)HALF * K * 2;
    const size_t tstep = 2 * hstep;
    const unsigned ldsw = (unsigned)wid * 1024u;
    const int aoff = lds_byte(wr * 64 + fr, fq * 8), boff = lds_byte(wc * 32 + fr, fq * 8);
#define PG8_SA(b, h) (((b) * 2 + (h)) * HTB)
#define PG8_SB(b, h) ((4 + (b) * 2 + (h)) * HTB)
#define PG8_STAGE(bufoff, gbase, voff) do { _Pragma("unroll") for (int _i = 0; _i < 2; ++_i) \
        __builtin_amdgcn_global_load_lds((const unsigned*)((const char*)(gbase) + (voff)[_i]), (PG8_LAS unsigned*)(lds + (bufoff) + ldsw + _i * 8192), 16, 0, 0); } while (0)
#define PG8_LDA(dst, b, h) do { _Pragma("unroll") for (int m = 0; m < 4; ++m) _Pragma("unroll") for (int k = 0; k < 2; ++k) dst[m][k] = *(const PG8_LAS bf16x8*)(lds + PG8_SA(b, h) + aoff + m * 2048 + k * 1024); } while (0)
#define PG8_LDB(dst, b, h) do { _Pragma("unroll") for (int n = 0; n < 2; ++n) _Pragma("unroll") for (int k = 0; k < 2; ++k) dst[n][k] = *(const PG8_LAS bf16x8*)(lds + PG8_SB(b, h) + boff + n * 2048 + k * 1024); } while (0)
#define PG8_MMA(ai, bj, At, Bt) do { __builtin_amdgcn_s_setprio(1); _Pragma("unroll") for (int m = 0; m < 4; ++m) _Pragma("unroll") for (int n = 0; n < 2; ++n) _Pragma("unroll") for (int k = 0; k < 2; ++k) \
        acc[ai][bj][m][n] = __builtin_amdgcn_mfma_f32_16x16x32_bf16(Bt[n][k], At[m][k], acc[ai][bj][m][n], 0, 0, 0); __builtin_amdgcn_s_setprio(0); } while (0)
#define PG8_WAIT_V(n) asm volatile("s_waitcnt vmcnt(" #n ")" ::: "memory")
#define PG8_WAIT_L(n) asm volatile("s_waitcnt lgkmcnt(" #n ")" ::: "memory")
#define PG8_BAR __builtin_amdgcn_s_barrier()
#define PG8_SCHED __builtin_amdgcn_sched_barrier(0)
    Unit cur, nxt; int ui = 0;
    if (!S.next(0, cur)) return;
    f32x4 acc[2][2][4][2];
#pragma unroll
    for (int a = 0; a < 2; ++a)
#pragma unroll
        for (int b = 0; b < 2; ++b)
#pragma unroll
            for (int m = 0; m < 4; ++m)
#pragma unroll
                for (int n = 0; n < 2; ++n) acc[a][b][m][n] = (f32x4){0.f, 0.f, 0.f, 0.f};
    bf16x8 At[4][2], B0[2][2], B1[2][2];
    const char* cA = (const char*)g.A + (size_t)cur.pm * tstep; const char* cB = (const char*)g.Bt + (size_t)cur.pn * tstep;
    S.a_ready(cur);
    if constexpr (SP2) {
        PG8_STAGE(PG8_SB(0, 0), cB, voffB); PG8_STAGE(PG8_SB(0, 1), cB + hstep, voffB); PG8_STAGE(PG8_SA(0, 0), cA, voffA); PG8_STAGE(PG8_SA(0, 1), cA + hstep, voffA);
        if (wr == 1) PG8_BAR;
        PG8_WAIT_V(2); PG8_BAR;
        PG8_STAGE(PG8_SB(1, 0), cB + kstep, voffB); PG8_STAGE(PG8_SA(1, 0), cA + kstep, voffA); PG8_STAGE(PG8_SB(1, 1), cB + hstep + kstep, voffB);
        PG8_WAIT_V(6); PG8_BAR;
    } else {
        PG8_STAGE(PG8_SB(0, 0), cB, voffB); PG8_STAGE(PG8_SA(0, 0), cA, voffA); PG8_STAGE(PG8_SB(0, 1), cB + hstep, voffB); PG8_STAGE(PG8_SA(0, 1), cA + hstep, voffA);
        if (wr == 1) PG8_BAR;
        PG8_WAIT_V(4); PG8_BAR;
        PG8_STAGE(PG8_SB(1, 0), cB + kstep, voffB); PG8_STAGE(PG8_SA(1, 0), cA + kstep, voffA); PG8_STAGE(PG8_SB(1, 1), cB + hstep + kstep, voffB);
        PG8_WAIT_V(6); PG8_BAR;
    }
    for (;;) {
        const bool has_next = S.next(ui + 1, nxt);
        const char* nA = has_next ? (const char*)g.A + (size_t)nxt.pm * tstep : cA; const char* nB = has_next ? (const char*)g.Bt + (size_t)nxt.pn * tstep : cB;
        for (int t = 0; t < nt; t += 2) {
            const bool last = (t == nt - 2);
            const char* a1 = cA + (size_t)(t + 1) * kstep;
            const char* a2 = last ? nA : cA + (size_t)(t + 2) * kstep; const char* b2 = last ? nB : cB + (size_t)(t + 2) * kstep;
            const char* a3 = a2 + kstep; const char* b3 = b2 + kstep;
            if (last && has_next) S.a_ready(nxt);
            if constexpr (SP2) {
            PG8_LDB(B0, 0, 0); PG8_LDB(B1, 0, 1); PG8_SCHED; PG8_LDA(At, 0, 0); PG8_STAGE(PG8_SA(1, 1), a1 + hstep, voffA);
            PG8_WAIT_V(8); PG8_WAIT_L(0); PG8_BAR; PG8_MMA(0, 0, At, B0); PG8_MMA(0, 1, At, B1); PG8_BAR; PG8_SCHED;
            PG8_LDA(At, 0, 1); PG8_STAGE(PG8_SB(0, 0), b2, voffB); PG8_STAGE(PG8_SB(0, 1), b2 + hstep, voffB); PG8_STAGE(PG8_SA(0, 0), a2, voffA);
            PG8_WAIT_V(8); PG8_WAIT_L(0); PG8_BAR; PG8_MMA(1, 0, At, B0); PG8_MMA(1, 1, At, B1); PG8_BAR; PG8_SCHED;
            PG8_LDB(B0, 1, 0); PG8_LDB(B1, 1, 1); PG8_SCHED; PG8_LDA(At, 1, 0); PG8_STAGE(PG8_SA(0, 1), a2 + hstep, voffA);
            PG8_WAIT_V(8); PG8_WAIT_L(0); PG8_BAR; PG8_MMA(0, 0, At, B0); PG8_MMA(0, 1, At, B1); PG8_BAR; PG8_SCHED;
            PG8_LDA(At, 1, 1); PG8_STAGE(PG8_SB(1, 0), b3, voffB); PG8_STAGE(PG8_SB(1, 1), b3 + hstep, voffB); PG8_STAGE(PG8_SA(1, 0), a3, voffA);
            PG8_WAIT_V(8); PG8_WAIT_L(0); PG8_BAR; PG8_MMA(1, 0, At, B0); PG8_MMA(1, 1, At, B1); PG8_BAR; PG8_SCHED;
            } else {
            PG8_LDB(B0, 0, 0); PG8_SCHED; PG8_LDA(At, 0, 0); PG8_STAGE(PG8_SA(1, 1), a1 + hstep, voffA);
            PG8_WAIT_L(8); PG8_BAR; PG8_WAIT_L(0); PG8_MMA(0, 0, At, B0); PG8_BAR; PG8_SCHED;
            PG8_LDB(B1, 0, 1); PG8_STAGE(PG8_SB(0, 0), b2, voffB);
            PG8_BAR; PG8_WAIT_L(0); PG8_MMA(0, 1, At, B1); PG8_BAR;
            PG8_LDA(At, 0, 1); PG8_STAGE(PG8_SA(0, 0), a2, voffA);
            PG8_BAR; PG8_WAIT_L(0); PG8_MMA(1, 0, At, B0); PG8_BAR; PG8_SCHED;
            PG8_STAGE(PG8_SB(0, 1), b2 + hstep, voffB);
            PG8_WAIT_V(6); PG8_BAR; PG8_MMA(1, 1, At, B1); PG8_BAR;
            PG8_LDB(B0, 1, 0); PG8_SCHED; PG8_LDA(At, 1, 0); PG8_STAGE(PG8_SA(0, 1), a2 + hstep, voffA);
            PG8_WAIT_L(8); PG8_BAR; PG8_WAIT_L(0); PG8_MMA(0, 0, At, B0); PG8_BAR; PG8_SCHED;
            PG8_LDB(B1, 1, 1); PG8_STAGE(PG8_SB(1, 0), b3, voffB);
            PG8_BAR; PG8_WAIT_L(0); PG8_MMA(0, 1, At, B1); PG8_BAR;
            PG8_LDA(At, 1, 1); PG8_STAGE(PG8_SA(1, 0), a3, voffA);
            PG8_BAR; PG8_WAIT_L(0); PG8_MMA(1, 0, At, B0); PG8_BAR; PG8_SCHED;
            PG8_STAGE(PG8_SB(1, 1), b3 + hstep, voffB);
            PG8_WAIT_V(6); PG8_BAR; PG8_MMA(1, 1, At, B1); PG8_BAR;
            }
        }
        if constexpr (ALIGN_EPI) { if (wr == 0) PG8_BAR; }
        if constexpr (!Epi::AFTER_DRAIN) { E(acc, cur, wr, wc, fr, fq); S.done(cur); }
        if (!has_next) break;
#pragma unroll
        for (int a = 0; a < 2; ++a)
#pragma unroll
            for (int b = 0; b < 2; ++b)
#pragma unroll
                for (int m = 0; m < 4; ++m)
#pragma unroll
                    for (int n = 0; n < 2; ++n) acc[a][b][m][n] = (f32x4){0.f, 0.f, 0.f, 0.f};
        cur = nxt; cA = nA; cB = nB; ++ui;
        if constexpr (ALIGN_EPI) { if (wr == 1) PG8_BAR; }
    }
    PG8_WAIT_V(0);
    if constexpr (!ALIGN_EPI) { if (wr == 0) PG8_BAR; }
    PG8_BAR;
    if constexpr (Epi::AFTER_DRAIN) { E.fused(acc, cur, wr, wc, fr, fq, lds, wid, lane); S.done(cur); }
#undef PG8_SA
#undef PG8_SB
#undef PG8_STAGE
#undef PG8_LDA
#undef PG8_LDB
#undef PG8_MMA
#undef PG8_WAIT_V
#undef PG8_WAIT_L
#undef PG8_BAR
#undef PG8_SCHED
}
}
#define LAS __attribute__((address_space(3)))
typedef unsigned short bf16;
typedef unsigned u32x4 __attribute__((ext_vector_type(4)));
typedef unsigned u32x2 __attribute__((ext_vector_type(2)));
typedef float f32x4 __attribute__((ext_vector_type(4)));
typedef float f32x16 __attribute__((ext_vector_type(16)));
typedef short bf16x8 __attribute__((ext_vector_type(8)));
using pg8::pkbf; using pg8::bf_lo; using pg8::bf_hi; using pg8::shx; using pg8::add_x32; using pg8::max_x32;

constexpr int NWAVES = 8, NTHR = 512;
constexpr int MTOK = 16384, SEQL = 8192, DM = 1024;
constexpr float EPSF = 1e-6f, LOG2E = 1.4426950408889634f;
constexpr float QSCALE = 0.10206207261596577f * 1.4426950408889634f;
constexpr int LDS_BYTES = 131072 + 256;

struct Params {
    const float* x; const int* pos; const float *g_mix, *w_in, *g_q_a, *w_q_b, *g_kv_a, *w_kv_b, *g_qn, *g_kn, *w_mla_out, *dec_f, *dec_b, *w_ret_out, *w_out, *g_ffn, *w_gate_up, *w_down;
    float* out; unsigned char* ws;
};

__device__ __forceinline__ int crow(int r, int hi) { return (r & 3) + 8 * (r >> 2) + 4 * hi; }
__device__ __forceinline__ float ex2(float x) { return __builtin_amdgcn_exp2f(x); }
#define MFMA32(a, b, c) __builtin_amdgcn_mfma_f32_32x32x16_bf16((a), (b), (c), 0, 0, 0)
#define LDS_WAIT() asm volatile("s_waitcnt lgkmcnt(0)" ::: "memory")

__device__ __forceinline__ void cvt_item(const float* __restrict__ W, int N, bf16* WT, int K, int k0, int n0, int drow0, const float* gk, LAS float* scr, int lane) {
    float v[32];
#pragma unroll
    for (int i = 0; i < 32; ++i) { const int kk = 2 * i + (lane >> 5); v[i] = __builtin_nontemporal_load(W + (size_t)(k0 + kk) * N + n0 + (lane & 31)); }
#pragma unroll
    for (int i = 0; i < 32; ++i) { const int kk = 2 * i + (lane >> 5); float x = v[i]; if (gk) x *= gk[k0 + kk]; scr[kk * 33 + (lane & 31)] = x; }
    LDS_WAIT();
    const int c = lane & 7;
#pragma unroll
    for (int j = 0; j < 4; ++j) { const int n = (lane >> 3) + 8 * j; const LAS float* s = scr + (8 * c) * 33 + n;
        u32x4 o; o.x = pkbf(s[0 * 33], s[1 * 33]); o.y = pkbf(s[2 * 33], s[3 * 33]); o.z = pkbf(s[4 * 33], s[5 * 33]); o.w = pkbf(s[6 * 33], s[7 * 33]);
        *(u32x4*)(WT + (size_t)(drow0 + n) * K + k0 + 8 * c) = o; }
    LDS_WAIT();
}
__device__ __forceinline__ int win_row(int n0) {
    if (n0 < 256) return n0;
    if (n0 < 416) return 256 + (n0 - 256);
    if (n0 < 1440) { const int isk = n0 >= 928; const int j = n0 - (isk ? 928 : 416); const int head = j >> 6, d = j & 63;
        return (isk ? 1024 : 512) + 256 * (head >> 2) + 128 * (d >> 5) + 32 * (head & 3) + (d & 31); }
    if (n0 < 2464) return 1536 + (n0 - 1440);
    if (n0 < 3488) return 2560 + (n0 - 2464);
    { const int j = n0 - 3488, br = j >> 10, ch = j & 1023; return 3584 + 256 * (ch >> 7) + 128 * br + (ch & 127); }
}
__device__ __forceinline__ int wgu_row(int n0) { const int up = n0 >= 2816; const int j = n0 - (up ? 2816 : 0); return 256 * (j >> 7) + 128 * up + (j & 127); }
__device__ __forceinline__ float wave_sum(float v) {
    v += shx<1>(v); v += shx<2>(v); v += shx<4>(v); v += shx<8>(v); v += shx<16>(v);
    return add_x32(v);
}
__device__ __forceinline__ void p0_late_weights(const Params& P, LAS unsigned char* lds, int tid, int gw, int NGW) {
    const int lane = tid & 63, wave = tid >> 6;
    unsigned char* ws = P.ws;
    LAS float* scr = (LAS float*)(lds + wave * 16384);
    constexpr int I3 = 8 * 32, I4 = 16 * 32, I5 = 16 * 32, I6 = 16 * 176, I7 = 44 * 32;
    constexpr int NITEMS = I3 + I4 + I5 + I6 + I7;
    for (int it = gw; it < NITEMS; it += NGW) {
        int r = it;
        if (r < I3) { const int kb = r / 32, nb = r % 32; cvt_item(P.w_mla_out, 1024, (bf16*)(ws + WS_WMLA), 512, 64 * kb, 32 * nb, 32 * nb, nullptr, scr, lane); continue; } r -= I3;
        if (r < I4) { const int kb = r / 32, nb = r % 32; cvt_item(P.w_ret_out, 1024, (bf16*)(ws + WS_WRET), 1024, 64 * kb, 32 * nb, 32 * nb, nullptr, scr, lane); continue; } r -= I4;
        if (r < I5) { const int kb = r / 32, nb = r % 32; cvt_item(P.w_out, 1024, (bf16*)(ws + WS_WOUT), 1024, 64 * kb, 32 * nb, 32 * nb, nullptr, scr, lane); continue; } r -= I5;
        if (r < I6) { const int kb = r / 176, nb = r % 176; cvt_item(P.w_gate_up, 5632, (bf16*)(ws + WS_WGU), 1024, 64 * kb, 32 * nb, wgu_row(32 * nb), P.g_ffn, scr, lane); continue; } r -= I6;
        { const int kb = r / 32, nb = r % 32; cvt_item(P.w_down, 1024, (bf16*)(ws + WS_WDN), 2816, 64 * kb, 32 * nb, 32 * nb, nullptr, scr, lane); }
    }
    const int gt = gw * 64 + lane, NGT = NGW * 64;
    for (int i0 = gt; i0 < MTOK * 48; i0 += 8 * NGT) {
        int pv[8];
#pragma unroll
        for (int k = 0; k < 8; ++k) { const int i = i0 + k * NGT; const int tok = (i < MTOK * 32) ? (i >> 5) : ((i - MTOK * 32) >> 4); pv[k] = (i < MTOK * 48) ? P.pos[tok] : 0; }
#pragma unroll
        for (int k = 0; k < 8; ++k) {
            const int i = i0 + k * NGT;
            if (i < MTOK * 48) {
                int f; float inv; float *cd, *sd;
                if (i < MTOK * 32) { f = i & 31; inv = exp2f(-(float)f * (13.287712379549449f / 32.0f)); cd = (float*)(ws + WS_COSR) + i; sd = (float*)(ws + WS_SINR) + i; }
                else { const int k2 = i - MTOK * 32; f = k2 & 15; inv = exp2f(-(float)f * (13.287712379549449f / 16.0f)); cd = (float*)(ws + WS_COSA) + k2; sd = (float*)(ws + WS_SINA) + k2; }
                const float ang = (float)pv[k] * inv;
                double rev = (double)ang * 0.15915494309189535; rev -= rint(rev);
                const float fr = (float)rev;
                *cd = __builtin_amdgcn_cosf(fr); *sd = __builtin_amdgcn_sinf(fr);
            }
        }
    }
}
__device__ __forceinline__ void p0_prologue(const Params& P, LAS unsigned char* lds, int tid, bool late_in_p0) {
    const int lane = tid & 63, wave = tid >> 6;
    unsigned char* ws = P.ws;
    LAS float* scr = (LAS float*)(lds + wave * 16384);
    const int gw = blockIdx.x * NWAVES + wave, NGW = gridDim.x * NWAVES;
    constexpr int I0 = 16 * 173, I1 = 4 * 24, I2 = 2 * 32;
    constexpr int NITEMS = I0 + I1 + I2;
    for (int it = gw; it < NITEMS; it += NGW) {
        int r = it;
        if (r < I0) { const int kb = r / 173, nb = r % 173; cvt_item(P.w_in, 5536, (bf16*)(ws + WS_WIN), 1024, 64 * kb, 32 * nb, win_row(32 * nb), nullptr, scr, lane); continue; } r -= I0;
        if (r < I1) { const int kb = r / 24, nb = r % 24; cvt_item(P.w_q_b, 768, (bf16*)(ws + WS_WQB), 256, 64 * kb, 32 * nb, 32 * nb, P.g_q_a, scr, lane); continue; } r -= I1;
        { const int kb = r / 32, nb = r % 32; cvt_item(P.w_kv_b, 1024, (bf16*)(ws + WS_WKVB), 128, 64 * kb, 32 * nb, 32 * nb, P.g_kv_a, scr, lane); }
    }
    if (late_in_p0) p0_late_weights(P, lds, tid, gw, NGW);
    const int gt = blockIdx.x * NTHR + tid, NGT = gridDim.x * NTHR;
    for (int i = gt; i < 12288; i += NGT) *((u32x4*)(ws + WS_WIN + (size_t)416 * 2048) + i) = (u32x4){0u, 0u, 0u, 0u};
    bf16* XN = (bf16*)(ws + WS_XN);
    f32x4 gm[4];
#pragma unroll
    for (int j = 0; j < 4; ++j) gm[j] = *((const f32x4*)P.g_mix + lane + 64 * j);
    for (int m0 = 4 * gw; m0 < MTOK; m0 += 4 * NGW) {
        f32x4 v[4][4];
#pragma unroll
        for (int q = 0; q < 4; ++q)
#pragma unroll
            for (int j = 0; j < 4; ++j) v[q][j] = __builtin_nontemporal_load((const f32x4*)(P.x + (size_t)(m0 + q) * DM) + lane + 64 * j);
#pragma unroll
        for (int q = 0; q < 4; ++q) {
            float s = 0.f;
#pragma unroll
            for (int j = 0; j < 4; ++j) s += (v[q][j][0] * v[q][j][0] + v[q][j][1] * v[q][j][1]) + (v[q][j][2] * v[q][j][2] + v[q][j][3] * v[q][j][3]);
            const float rstd = rsqrtf(wave_sum(s) * (1.f / DM) + EPSF);
            u32x2* o8 = (u32x2*)(XN + (size_t)(m0 + q) * DM) + lane;
#pragma unroll
            for (int j = 0; j < 4; ++j) { u32x2 w; w.x = pkbf(v[q][j][0] * rstd * gm[j][0], v[q][j][1] * rstd * gm[j][1]); w.y = pkbf(v[q][j][2] * rstd * gm[j][2], v[q][j][3] * rstd * gm[j][3]); o8[64 * j] = w; }
        }
    }
}

__device__ __forceinline__ void unpack8(const u32x4 w, float (&f)[8]) {
#pragma unroll
    for (int i = 0; i < 4; ++i) { f[2 * i] = bf_lo(w[i]); f[2 * i + 1] = bf_hi(w[i]); }
}
__device__ __forceinline__ u32x4 pack8(const float (&f)[8]) { u32x4 o; o.x = pkbf(f[0], f[1]); o.y = pkbf(f[2], f[3]); o.z = pkbf(f[4], f[5]); o.w = pkbf(f[6], f[7]); return o; }
__device__ __forceinline__ float ssq8(const u32x4 w) { float s = 0.f;
#pragma unroll
    for (int i = 0; i < 4; ++i) { const float a = bf_lo(w[i]), b = bf_hi(w[i]); s += a * a + b * b; }
    return s; }
__device__ __forceinline__ void norm_rope_head(const u32x4* pa, float sa, const u32x4* pb, float sb, float s1, float s2, const float* __restrict__ gain, const float* cs, const float* sn, float oscale, u32x4* dst) {
    const float rn = rsqrtf((sa * sa * s1 + sb * sb * s2) * (1.f / 96.f) + EPSF) * oscale;
    const float fa = sa * rn, fb = sb * rn;
#pragma unroll 4
    for (int c = 0; c < 8; ++c) {
        float f[8]; unpack8(pa[c], f);
        const f32x4 g0 = *(const f32x4*)(gain + 8 * c), g1 = *(const f32x4*)(gain + 8 * c + 4);
#pragma unroll
        for (int i = 0; i < 4; ++i) { f[i] *= fa * g0[i]; f[4 + i] *= fa * g1[i]; }
        dst[c] = pack8(f);
    }
#pragma unroll
    for (int c = 0; c < 2; ++c) {
        float x1[8], x2[8]; unpack8(pb[c], x1); unpack8(pb[2 + c], x2);
        const f32x4 ga0 = *(const f32x4*)(gain + 64 + 8 * c), ga1 = *(const f32x4*)(gain + 68 + 8 * c), gb0 = *(const f32x4*)(gain + 80 + 8 * c), gb1 = *(const f32x4*)(gain + 84 + 8 * c);
        const f32x4 c0 = *(const f32x4*)(cs + 8 * c), c1 = *(const f32x4*)(cs + 8 * c + 4), n0 = *(const f32x4*)(sn + 8 * c), n1 = *(const f32x4*)(sn + 8 * c + 4);
        float o1[8], o2[8];
#pragma unroll
        for (int i = 0; i < 4; ++i) {
            const float a = x1[i] * fb * ga0[i], bq = x2[i] * fb * gb0[i]; o1[i] = a * c0[i] - bq * n0[i]; o2[i] = bq * c0[i] + a * n0[i];
            const float a2 = x1[4 + i] * fb * ga1[i], b2 = x2[4 + i] * fb * gb1[i]; o1[4 + i] = a2 * c1[i] - b2 * n1[i]; o2[4 + i] = b2 * c1[i] + a2 * n1[i];
        }
        dst[8 + c] = pack8(o1); dst[10 + c] = pack8(o2);
    }
}
__device__ __forceinline__ void norm_rope_head_r(const u32x4 (&w)[12], float sa, float sb, float s1, float s2, const float* __restrict__ gain, const float* cs, const float* sn, float oscale, u32x4* dst) {
    const float rn = rsqrtf((sa * sa * s1 + sb * sb * s2) * (1.f / 96.f) + EPSF) * oscale;
    const float fa = sa * rn, fb = sb * rn;
#pragma unroll
    for (int c = 0; c < 8; ++c) {
        float f[8]; unpack8(w[c], f);
        const f32x4 g0 = *(const f32x4*)(gain + 8 * c), g1 = *(const f32x4*)(gain + 8 * c + 4);
#pragma unroll
        for (int i = 0; i < 4; ++i) { f[i] *= fa * g0[i]; f[4 + i] *= fa * g1[i]; }
        dst[c] = pack8(f);
    }
#pragma unroll
    for (int c = 0; c < 2; ++c) {
        float x1[8], x2[8]; unpack8(w[8 + c], x1); unpack8(w[10 + c], x2);
        const f32x4 ga0 = *(const f32x4*)(gain + 64 + 8 * c), ga1 = *(const f32x4*)(gain + 68 + 8 * c), gb0 = *(const f32x4*)(gain + 80 + 8 * c), gb1 = *(const f32x4*)(gain + 84 + 8 * c);
        const f32x4 c0 = *(const f32x4*)(cs + 8 * c), c1 = *(const f32x4*)(cs + 8 * c + 4), n0 = *(const f32x4*)(sn + 8 * c), n1 = *(const f32x4*)(sn + 8 * c + 4);
        float o1[8], o2[8];
#pragma unroll
        for (int i = 0; i < 4; ++i) {
            const float a = x1[i] * fb * ga0[i], bq = x2[i] * fb * gb0[i]; o1[i] = a * c0[i] - bq * n0[i]; o2[i] = bq * c0[i] + a * n0[i];
            const float a2 = x1[4 + i] * fb * ga1[i], b2 = x2[4 + i] * fb * gb1[i]; o1[4 + i] = a2 * c1[i] - b2 * n1[i]; o2[4 + i] = b2 * c1[i] + a2 * n1[i];
        }
        dst[8 + c] = pack8(o1); dst[10 + c] = pack8(o2);
    }
}
__device__ __forceinline__ void mla_prep(const Params& P, int tid) {
    unsigned char* ws = P.ws;
    const bf16* CQ = (const bf16*)(ws + WS_CQ); const bf16* CKV = (const bf16*)(ws + WS_CKV); const bf16* KROPE = (const bf16*)(ws + WS_KROPE);
    const bf16* UQ = (const bf16*)(ws + WS_UQ); const bf16* UKV = (const bf16*)(ws + WS_UKV);
    bf16* AQ = (bf16*)(ws + WS_AQ); bf16* AK = (bf16*)(ws + WS_AK); bf16* AV = (bf16*)(ws + WS_AV);
    const float* cosA = (const float*)(ws + WS_COSA); const float* sinA = (const float*)(ws + WS_SINA);
    for (int tile = blockIdx.x; tile < MTOK / 64; tile += gridDim.x) {
        const int tk = tid >> 3, hd = tid & 7, row = tile * 64 + tk, b = row >> 13, s = row & (SEQL - 1);
        const u32x4* pq = (const u32x4*)(UQ + (size_t)row * 768 + 96 * hd);
        const u32x4* pk = (const u32x4*)(UKV + (size_t)row * 1024 + 128 * hd);
        const u32x4* pr = (const u32x4*)(KROPE + (size_t)row * 32);
        const size_t orow = (size_t)(b * 8 + hd) * SEQL + s;
        const float* cs = cosA + (size_t)row * 16; const float* sn = sinA + (size_t)row * 16;
        float sq = 0.f, skv = 0.f, sq1 = 0.f, sq2 = 0.f, sk1 = 0.f, sk2 = 0.f;
        float rq, rkv;
        {
            u32x4 wq[4], wkv[2], wu[12];
            { const u32x4* p = (const u32x4*)(CQ + (size_t)row * 256 + 32 * hd);
#pragma unroll
              for (int c = 0; c < 4; ++c) wq[c] = p[c]; }
            { const u32x4* p = (const u32x4*)(CKV + (size_t)row * 128 + 16 * hd);
#pragma unroll
              for (int c = 0; c < 2; ++c) wkv[c] = p[c]; }
#pragma unroll
            for (int c = 0; c < 12; ++c) wu[c] = pq[c];
#pragma unroll
            for (int c = 0; c < 4; ++c) sq += ssq8(wq[c]);
#pragma unroll
            for (int c = 0; c < 2; ++c) skv += ssq8(wkv[c]);
#pragma unroll
            for (int c = 0; c < 8; ++c) sq1 += ssq8(wu[c]);
#pragma unroll
            for (int c = 8; c < 12; ++c) sq2 += ssq8(wu[c]);
            sq += shx<1>(sq); sq += shx<2>(sq); sq += shx<4>(sq);
            skv += shx<1>(skv); skv += shx<2>(skv); skv += shx<4>(skv);
            rq = rsqrtf(sq * (1.f / 256.f) + EPSF); rkv = rsqrtf(skv * (1.f / 128.f) + EPSF);
            norm_rope_head_r(wu, rq, rq, sq1, sq2, P.g_qn, cs, sn, QSCALE, (u32x4*)(AQ + orow * 96));
        }
        asm volatile("" ::: "memory");
        {
            u32x4 wk[12], wv[8];
#pragma unroll
            for (int c = 0; c < 8; ++c) { wk[c] = pk[c]; wv[c] = pk[8 + c]; }
#pragma unroll
            for (int c = 0; c < 4; ++c) wk[8 + c] = pr[c];
#pragma unroll
            for (int c = 0; c < 8; ++c) sk1 += ssq8(wk[c]);
#pragma unroll
            for (int c = 8; c < 12; ++c) sk2 += ssq8(wk[c]);
            norm_rope_head_r(wk, rkv, 1.f, sk1, sk2, P.g_kn, cs, sn, 1.f, (u32x4*)(AK + orow * 96));
            u32x4* qv = (u32x4*)(AV + orow * 64);
#pragma unroll
            for (int c = 0; c < 8; ++c) { float f[8]; unpack8(wv[c], f);
#pragma unroll
                for (int i = 0; i < 8; ++i) f[i] *= rkv;
                qv[c] = pack8(f); }
        }
    }
}

constexpr int KPITCH = 208, VPITCH = 144, KBUF = 64 * KPITCH, VBUF = 64 * VPITCH;
constexpr int AT_K0 = 0, AT_V0 = 3 * KBUF;
constexpr float ATT_THR = 16.0f;
__device__ __forceinline__ float max3f(float a, float b, float c) { float r; asm("v_max3_f32 %0, %1, %2, %3" : "=v"(r) : "v"(a), "v"(b), "v"(c)); return r; }
template <bool LATE, bool NOMAX>
__device__ __forceinline__ void attn_unit(LAS unsigned char* lds, const bf16* AQ, const bf16* AK, const bf16* AV, bf16* AO, int bh, int qb, int tid) {
    const int lane = tid & 63, wid = tid >> 6, r32 = lane & 31, hi = lane >> 5;
    constexpr int NT = SEQL / 64;
    const size_t rowQ = (size_t)bh * SEQL + qb * 256 + wid * 32 + r32;
    bf16x8 qf[6];
#pragma unroll
    for (int s = 0; s < 6; ++s) qf[s] = *(const bf16x8*)(AQ + rowQ * 96 + 16 * s + 8 * hi);
    const unsigned char* Kg = (const unsigned char*)(AK + (size_t)bh * SEQL * 96);
    const unsigned char* Vg = (const unsigned char*)(AV + (size_t)bh * SEQL * 64);
    const int t2 = tid & 255;
    unsigned koff[3];
#pragma unroll
    for (int j = 0; j < 3; ++j) { const int c = t2 + 256 * j; koff[j] = (c / 12) * KPITCH + (c % 12) * 16; }
    const int vkey = t2 & 63, vdch = t2 >> 6, k15 = vkey & 15;
    const int vpos = 16 * (vkey >> 4) + (k15 & 3) + 4 * ((k15 >> 3) & 1) + 8 * ((k15 >> 2) & 1);
    const unsigned voff = (8 * vdch) * VPITCH + vpos * 2, vgoff = vkey * 128 + vdch * 16;
    f32x16 o0, o1, S0, S1, zero16;
#pragma unroll
    for (int r = 0; r < 16; ++r) { o0[r] = 0.f; o1[r] = 0.f; zero16[r] = 0.f; }
    float m = 0.f, lsum = 0.f;
    u32x4 kr[3], vr[2];
    const int rot = 4 * qb;
#define AT_TT(t) (((t) + rot) & (NT - 1))
#define AT_LOADK(t) do { if (!LATE) { const unsigned char* kg_ = Kg + (size_t)AT_TT(t) * 12288 + t2 * 16; _Pragma("unroll") for (int j = 0; j < 3; ++j) kr[j] = *(const u32x4*)(kg_ + 4096 * j); } } while (0)
#define AT_LOADV(t) do { if (!LATE) { const unsigned char* vg_ = Vg + (size_t)AT_TT(t) * 8192 + vgoff; vr[0] = *(const u32x4*)vg_; vr[1] = *(const u32x4*)(vg_ + 64); } } while (0)
#define AT_WRITEK(slot) do { if (!LATE) { _Pragma("unroll") for (int j = 0; j < 3; ++j) *(LAS u32x4*)(lds + AT_K0 + (slot) * KBUF + koff[j]) = kr[j]; } } while (0)
#define AT_WRITEV(slot) do { if (!LATE) { _Pragma("unroll") for (int jv = 0; jv < 2; ++jv) { LAS unsigned char* vb_ = lds + AT_V0 + (slot) * VBUF + voff + jv * 32 * VPITCH; \
        _Pragma("unroll") for (int e = 0; e < 8; ++e) *(LAS unsigned short*)(vb_ + e * VPITCH) = (unsigned short)((e & 1) ? (vr[jv][e >> 1] >> 16) : (vr[jv][e >> 1] & 0xffffu)); } } } while (0)
#define AT_KLOAD(slot) do { const LAS unsigned char* kb_ = lds + AT_K0 + (slot) * KBUF + r32 * KPITCH + 16 * hi; \
        _Pragma("unroll") for (int s = 0; s < 6; ++s) { kf0[s] = *(const LAS bf16x8*)(kb_ + 32 * s); kf1[s] = *(const LAS bf16x8*)(kb_ + 32 * KPITCH + 32 * s); } } while (0)
#define AT_VLOAD(slot) do { const LAS unsigned char* vb_ = lds + AT_V0 + (slot) * VBUF + r32 * VPITCH + 16 * hi; \
        _Pragma("unroll") for (int ks = 0; ks < 4; ++ks) { vf0[ks] = *(const LAS bf16x8*)(vb_ + 32 * ks); vf1[ks] = *(const LAS bf16x8*)(vb_ + 32 * VPITCH + 32 * ks); } } while (0)
#define AT_QK() do { __builtin_amdgcn_s_setprio(1); \
        _Pragma("unroll") for (int s = 0; s < 6; ++s) { \
            if (s == 0) { S0 = MFMA32(kf0[0], qf[0], zero16); S1 = MFMA32(kf1[0], qf[0], zero16); } else { S0 = MFMA32(kf0[s], qf[s], S0); S1 = MFMA32(kf1[s], qf[s], S1); } } __builtin_amdgcn_s_setprio(0); } while (0)
    bf16x8 kf0[6], kf1[6], vf0[4], vf1[4];
    AT_LOADK(0); AT_LOADV(0); AT_WRITEK(0); AT_WRITEV(0); AT_LOADK(1); AT_WRITEK(1);
    __syncthreads();
    AT_KLOAD(0);
    if (LATE) AT_QK();
    int ks_cur = 0, ks_nxt = 1, ks_wr = 2;
    for (int kt = 0; kt < NT; ++kt) {
        const int vcur = kt & 1;
        if (kt + 2 < NT) AT_LOADK(kt + 2);
        if (kt + 1 < NT) AT_LOADV(kt + 1);
        AT_VLOAD(vcur);
        if (LATE) { if (kt + 1 < NT) AT_KLOAD(ks_nxt); }
        __builtin_amdgcn_sched_barrier(0);
        if (!LATE) AT_QK();
        if (!NOMAX) {
            if (__any(m != 0.f)) {
    #pragma unroll
                for (int r = 0; r < 16; ++r) { S0[r] -= m; S1[r] -= m; }
            }
            asm volatile("s_nop 15\n\ts_nop 15" : "+v"(S0), "+v"(S1));
            float mx;
            { float a_ = max3f(S0[0], S0[1], S1[0]), b_ = max3f(S0[2], S0[3], S1[1]); a_ = max3f(a_, S1[2], S1[3]);
    #pragma unroll
              for (int r = 4; r < 16; r += 4) { a_ = max3f(a_, S0[r], S0[r + 1]); b_ = max3f(b_, S0[r + 2], S0[r + 3]); a_ = max3f(a_, S1[r], S1[r + 1]); b_ = max3f(b_, S1[r + 2], S1[r + 3]); }
              mx = max3f(a_, b_, b_); }
            mx = max_x32(mx);
            if (__any(mx > ATT_THR) || (kt == 0 && __any(mx < -ATT_THR))) {
                const float dl = (mx > ATT_THR || kt == 0) ? mx : 0.f;
                const float al = ex2(-dl); m += dl;
    #pragma unroll
                for (int r = 0; r < 16; ++r) { o0[r] *= al; o1[r] *= al; S0[r] -= dl; S1[r] -= dl; }
                lsum *= al;
            }
        }
#pragma unroll
        for (int r = 0; r < 16; ++r) { S0[r] = ex2(S0[r]); S1[r] = ex2(S1[r]); }
#pragma unroll
        for (int r = 0; r < 16; ++r) { lsum += S0[r]; lsum += S1[r]; }
#pragma unroll
        for (int ks = 0; ks < 4; ++ks) {
            u32x4 pw;
            if (ks < 2) { pw.x = pkbf(S0[8 * ks], S0[8 * ks + 1]); pw.y = pkbf(S0[8 * ks + 2], S0[8 * ks + 3]); pw.z = pkbf(S0[8 * ks + 4], S0[8 * ks + 5]); pw.w = pkbf(S0[8 * ks + 6], S0[8 * ks + 7]); }
            else { const int k2 = ks - 2; pw.x = pkbf(S1[8 * k2], S1[8 * k2 + 1]); pw.y = pkbf(S1[8 * k2 + 2], S1[8 * k2 + 3]); pw.z = pkbf(S1[8 * k2 + 4], S1[8 * k2 + 5]); pw.w = pkbf(S1[8 * k2 + 6], S1[8 * k2 + 7]); }
            const bf16x8 pf = __builtin_bit_cast(bf16x8, pw);
            o0 = MFMA32(vf0[ks], pf, o0); o1 = MFMA32(vf1[ks], pf, o1);
        }
        if (LATE) { if (kt + 1 < NT) AT_QK(); }
        else { if (kt + 1 < NT) { AT_KLOAD(ks_nxt); __builtin_amdgcn_sched_barrier(0); } }
        if (kt + 2 < NT) AT_WRITEK(ks_wr);
        if (kt + 1 < NT) AT_WRITEV(vcur ^ 1);
        __syncthreads();
        { const int t_ = ks_cur; ks_cur = ks_nxt; ks_nxt = ks_wr; ks_wr = t_; }
    }
#undef AT_LOADK
#undef AT_TT
#undef AT_LOADV
#undef AT_WRITEK
#undef AT_WRITEV
#undef AT_QK
#undef AT_KLOAD
#undef AT_VLOAD
    const float il = 1.f / add_x32(lsum);
    const int b = bh >> 3, h = bh & 7;
    bf16* orow = AO + ((size_t)b * SEQL + qb * 256 + wid * 32 + r32) * 512 + h * 64 + 4 * hi;
#pragma unroll
    for (int g = 0; g < 4; ++g) {
        u32x2 w0, w1;
        w0.x = pkbf(o0[4 * g] * il, o0[4 * g + 1] * il); w0.y = pkbf(o0[4 * g + 2] * il, o0[4 * g + 3] * il);
        w1.x = pkbf(o1[4 * g] * il, o1[4 * g + 1] * il); w1.y = pkbf(o1[4 * g + 2] * il, o1[4 * g + 3] * il);
        *(u32x2*)(orow + 8 * g) = w0; *(u32x2*)(orow + 32 + 8 * g) = w1;
    }
}

__device__ __forceinline__ float lg2_of(const float* dec, int h) { return -expf(dec[h]) * LOG2E; }
__device__ __forceinline__ void ret_scan(const Params& P, int tid) {
    bf16* LT = (bf16*)(P.ws + WS_LT);
    const int gt = blockIdx.x * NTHR + tid, NGT = gridDim.x * NTHR;
    for (int e = gt; e < 2 * 16 * 8192; e += NGT) {
        const int dir = e >> 17, bh = (e >> 13) & 15, el = e & 8191, h = bh & 7;
        const float g = ex2(lg2_of(dir ? P.dec_b : P.dec_f, h) * 128.f);
        bf16* base = LT + (size_t)((dir * 16 + bh) * 64) * 8192 + el;
        float st = 0.f;
        for (int c8 = 0; c8 < 8; ++c8) {
            float L[8];
#pragma unroll
            for (int i = 0; i < 8; ++i) { const int c = dir ? 63 - (8 * c8 + i) : 8 * c8 + i; L[i] = __uint_as_float((unsigned)base[(size_t)c * 8192] << 16); }
#pragma unroll
            for (int i = 0; i < 8; ++i) { const int c = dir ? 63 - (8 * c8 + i) : 8 * c8 + i; base[(size_t)c * 8192] = (bf16)(pkbf(st, 0.f) & 0xffffu); st = st * g + L[i]; }
        }
    }
}
__device__ __forceinline__ void ret_local_lds(const Params& P, LAS unsigned char* lds, int tid) {
    constexpr int LK = 0, LKP = 144, LV = 128 * 144, LVP = 272;
    unsigned char* ws = P.ws;
    const bf16* RK = (const bf16*)(ws + WS_RK); const bf16* VR = (const bf16*)(ws + WS_VR); bf16* LT = (bf16*)(ws + WS_LT);
    const int lane = tid & 63, wid = tid >> 6, r32 = lane & 31, hi = lane >> 5, dvb = wid & 3, dkb = wid >> 2;
    const int kt0 = tid >> 3, kp0 = tid & 7;
    const int vtok = tid & 127, vp0 = tid >> 7, t15 = vtok & 15;
    const int vpos = 16 * (vtok >> 4) + (t15 & 3) + 4 * ((t15 >> 3) & 1) + 8 * ((t15 >> 2) & 1);
    u32x4 gk[2], gv[4];
#define RL_LOAD(item_) do { const int bh_ = (item_) >> 6, ch_ = (item_) & 63, b_ = bh_ >> 3, h_ = bh_ & 7; const size_t t0_ = (size_t)b_ * SEQL + ch_ * 128; \
        _Pragma("unroll") for (int j = 0; j < 2; ++j) gk[j] = *(const u32x4*)(RK + (t0_ + kt0 + 64 * j) * 512 + h_ * 64 + kp0 * 8); \
        _Pragma("unroll") for (int j = 0; j < 4; ++j) gv[j] = *(const u32x4*)(VR + (t0_ + vtok) * 1024 + h_ * 128 + (vp0 + 4 * j) * 8); } while (0)
#define RL_STORE() do { \
        _Pragma("unroll") for (int j = 0; j < 2; ++j) *(LAS u32x4*)(lds + LK + (kt0 + 64 * j) * LKP + kp0 * 16) = gk[j]; \
        _Pragma("unroll") for (int j = 0; j < 4; ++j) { LAS unsigned char* vb_ = lds + LV + (8 * (vp0 + 4 * j)) * LVP + vpos * 2; \
            _Pragma("unroll") for (int e = 0; e < 8; ++e) *(LAS unsigned short*)(vb_ + e * LVP) = (unsigned short)((e & 1) ? (gv[j][e >> 1] >> 16) : (gv[j][e >> 1] & 0xffffu)); } } while (0)
    int item = blockIdx.x;
    if (item < 1024) RL_LOAD(item);
    for (; item < 1024; item += gridDim.x) {
        const int bh = item >> 6, ch = item & 63, h = bh & 7;
        RL_STORE();
        __syncthreads();
        if (item + (int)gridDim.x < 1024) RL_LOAD(item + (int)gridDim.x);
        const float lgf = lg2_of(P.dec_f, h), lgb = lg2_of(P.dec_b, h);
        f32x16 accf, accb;
#pragma unroll
        for (int r = 0; r < 16; ++r) { accf[r] = 0.f; accb[r] = 0.f; }
        const LAS unsigned char* vb = lds + LV + (32 * dvb + r32) * LVP + 16 * hi; const LAS unsigned char* kb = lds + LK + (32 * dkb + r32) * 2;
#pragma unroll 2
        for (int s = 0; s < 8; ++s) {
            const bf16x8 af = *(const LAS bf16x8*)(vb + 32 * s);
            float kf[8], kq[8];
#pragma unroll
            for (int jj = 0; jj < 8; ++jj) {
                const int j = 16 * s + (jj & 3) + 8 * (jj >> 2) + 4 * hi;
                const float kv = __uint_as_float((unsigned)(*(const LAS unsigned short*)(kb + j * LKP)) << 16);
                kf[jj] = kv * ex2(lgf * (float)(127 - j)); kq[jj] = kv * ex2(lgb * (float)j);
            }
            u32x4 w0, w1;
            w0.x = pkbf(kf[0], kf[1]); w0.y = pkbf(kf[2], kf[3]); w0.z = pkbf(kf[4], kf[5]); w0.w = pkbf(kf[6], kf[7]);
            w1.x = pkbf(kq[0], kq[1]); w1.y = pkbf(kq[2], kq[3]); w1.z = pkbf(kq[4], kq[5]); w1.w = pkbf(kq[6], kq[7]);
            accf = MFMA32(af, __builtin_bit_cast(bf16x8, w0), accf); accb = MFMA32(af, __builtin_bit_cast(bf16x8, w1), accb);
        }
        bf16* opf = LT + ((size_t)((0 * 16 + bh) * 64 + ch) * 128 + 32 * dvb) * 64 + 32 * dkb + r32;
        bf16* opb = LT + ((size_t)((1 * 16 + bh) * 64 + ch) * 128 + 32 * dvb) * 64 + 32 * dkb + r32;
#pragma unroll
        for (int r = 0; r < 16; ++r) { const int dv = crow(r, hi); opf[(size_t)dv * 64] = (bf16)(pkbf(accf[r], 0.f) & 0xffffu); opb[(size_t)dv * 64] = (bf16)(pkbf(accb[r], 0.f) & 0xffffu); }
        __syncthreads();
    }
#undef RL_LOAD
#undef RL_STORE
}

constexpr int RO_KP = 144, RO_VP = 272, RO_SP = 144;
constexpr int RO_K = 0, RO_V = RO_K + 128 * RO_KP, RO_SF = RO_V + 128 * RO_VP, RO_SB = RO_SF + 128 * RO_SP, RO_X = RO_SB + 128 * RO_SP, RO_END = RO_X + 8 * 32 * 4;
__device__ __forceinline__ void ret_out_lds(const Params& P, LAS unsigned char* lds, int tid) {
    unsigned char* ws = P.ws;
    const bf16* RQ = (const bf16*)(ws + WS_RQ); const bf16* RK = (const bf16*)(ws + WS_RK); const bf16* VR = (const bf16*)(ws + WS_VR); const bf16* GR = (const bf16*)(ws + WS_GR);
    const bf16* ST = (const bf16*)(ws + WS_LT); bf16* OB = (bf16*)(ws + WS_OB);
    const int lane = tid & 63, wid = tid >> 6, r32 = lane & 31, hi = lane >> 5, ib = wid & 3, dvh = wid >> 2;
    const int kt0 = tid >> 3, kp0 = tid & 7;
    const int vtok = tid & 127, vp0 = tid >> 7, t15 = vtok & 15;
    const int vpos = 16 * (vtok >> 4) + (t15 & 3) + 4 * ((t15 >> 3) & 1) + 8 * ((t15 >> 2) & 1);
    u32x4 gk[2], gv[4], gf[2], gb[2];
#define RO_LOAD(item_) do { const int bh_ = (item_) >> 6, ch_ = (item_) & 63, b_ = bh_ >> 3, h_ = bh_ & 7; const size_t t0_ = (size_t)b_ * SEQL + ch_ * 128; \
        _Pragma("unroll") for (int j = 0; j < 2; ++j) gk[j] = *(const u32x4*)(RK + (t0_ + kt0 + 64 * j) * 512 + h_ * 64 + kp0 * 8); \
        _Pragma("unroll") for (int j = 0; j < 4; ++j) gv[j] = *(const u32x4*)(VR + (t0_ + vtok) * 1024 + h_ * 128 + (vp0 + 4 * j) * 8); \
        const bf16* sf_ = ST + (size_t)((0 * 16 + bh_) * 64 + ch_) * 8192; const bf16* sb_ = ST + (size_t)((1 * 16 + bh_) * 64 + ch_) * 8192; \
        _Pragma("unroll") for (int j = 0; j < 2; ++j) { gf[j] = *(const u32x4*)(sf_ + (kt0 + 64 * j) * 64 + kp0 * 8); gb[j] = *(const u32x4*)(sb_ + (kt0 + 64 * j) * 64 + kp0 * 8); } } while (0)
#define RO_STORE() do { \
        _Pragma("unroll") for (int j = 0; j < 2; ++j) { *(LAS u32x4*)(lds + RO_K + (kt0 + 64 * j) * RO_KP + kp0 * 16) = gk[j]; \
            *(LAS u32x4*)(lds + RO_SF + (kt0 + 64 * j) * RO_SP + kp0 * 16) = gf[j]; *(LAS u32x4*)(lds + RO_SB + (kt0 + 64 * j) * RO_SP + kp0 * 16) = gb[j]; } \
        _Pragma("unroll") for (int j = 0; j < 4; ++j) { LAS unsigned char* vb_ = lds + RO_V + (8 * (vp0 + 4 * j)) * RO_VP + vpos * 2; \
            _Pragma("unroll") for (int e = 0; e < 8; ++e) *(LAS unsigned short*)(vb_ + e * RO_VP) = (unsigned short)((e & 1) ? (gv[j][e >> 1] >> 16) : (gv[j][e >> 1] & 0xffffu)); } } while (0)
    int item = blockIdx.x;
    if (item < 1024) RO_LOAD(item);
    for (; item < 1024; item += gridDim.x) {
        const int bh = item >> 6, ch = item & 63, b = bh >> 3, h = bh & 7;
        const size_t tok0 = (size_t)b * SEQL + ch * 128;
        RO_STORE();
        __syncthreads();
        if (item + (int)gridDim.x < 1024) RO_LOAD(item + (int)gridDim.x);
        const int il = 32 * ib + r32;
        const float lgf = lg2_of(P.dec_f, h), lgb = lg2_of(P.dec_b, h);
        bf16x8 qf[4];
#pragma unroll
        for (int s = 0; s < 4; ++s) qf[s] = *(const bf16x8*)(RQ + (tok0 + il) * 512 + h * 64 + 16 * s + 8 * hi);
        f32x16 acc[2];
#pragma unroll
        for (int d = 0; d < 2; ++d)
#pragma unroll
            for (int r = 0; r < 16; ++r) acc[d][r] = 0.f;
        const LAS unsigned char* sfb = lds + RO_SF + (64 * dvh + r32) * RO_SP + 16 * hi; const LAS unsigned char* sbb = lds + RO_SB + (64 * dvh + r32) * RO_SP + 16 * hi;
#pragma unroll
        for (int d = 0; d < 2; ++d)
#pragma unroll
            for (int s = 0; s < 4; ++s) { const bf16x8 a = *(const LAS bf16x8*)(sfb + 32 * d * RO_SP + 32 * s); acc[d] = MFMA32(a, qf[s], acc[d]); }
        const float wb = ex2(lgb * (float)(128 - il)), ratio = ex2(lgf * (float)(il + 1) - lgb * (float)(128 - il));
#pragma unroll
        for (int d = 0; d < 2; ++d)
#pragma unroll
            for (int r = 0; r < 16; ++r) acc[d][r] *= ratio;
#pragma unroll
        for (int d = 0; d < 2; ++d)
#pragma unroll
            for (int s = 0; s < 4; ++s) { const bf16x8 a = *(const LAS bf16x8*)(sbb + 32 * d * RO_SP + 32 * s); acc[d] = MFMA32(a, qf[s], acc[d]); }
#pragma unroll
        for (int d = 0; d < 2; ++d)
#pragma unroll
            for (int r = 0; r < 16; ++r) acc[d][r] *= wb;
        const LAS unsigned char* kb = lds + RO_K + r32 * RO_KP + 16 * hi; const LAS unsigned char* vb = lds + RO_V + (64 * dvh + r32) * RO_VP + 16 * hi;
#pragma unroll 2
        for (int jb = 0; jb < 4; ++jb) {
            f32x16 st;
#pragma unroll
            for (int r = 0; r < 16; ++r) st[r] = 0.f;
#pragma unroll
            for (int s = 0; s < 4; ++s) { const bf16x8 a = *(const LAS bf16x8*)(kb + 32 * jb * RO_KP + 32 * s); st = MFMA32(a, qf[s], st); }
#pragma unroll
            for (int r = 0; r < 16; ++r) { const int df = il - (32 * jb + crow(r, hi)); st[r] *= (df >= 0) ? ex2(lgf * (float)df) : ex2(lgb * (float)(-df)); }
#pragma unroll
            for (int ks = 0; ks < 2; ++ks) {
                u32x4 pw; pw.x = pkbf(st[8 * ks], st[8 * ks + 1]); pw.y = pkbf(st[8 * ks + 2], st[8 * ks + 3]); pw.z = pkbf(st[8 * ks + 4], st[8 * ks + 5]); pw.w = pkbf(st[8 * ks + 6], st[8 * ks + 7]);
                const bf16x8 pf = __builtin_bit_cast(bf16x8, pw);
#pragma unroll
                for (int d = 0; d < 2; ++d) { const bf16x8 af = *(const LAS bf16x8*)(vb + 32 * d * RO_VP + (32 * jb + 16 * ks) * 2); acc[d] = MFMA32(af, pf, acc[d]); }
            }
        }
        float ss = 0.f;
#pragma unroll
        for (int d = 0; d < 2; ++d)
#pragma unroll
            for (int r = 0; r < 16; ++r) ss += acc[d][r] * acc[d][r];
        ss = add_x32(ss);
        LAS float* X = (LAS float*)(lds + RO_X);
        if (hi == 0) X[wid * 32 + r32] = ss;
        __syncthreads();
        ss += X[(wid ^ 4) * 32 + r32];
        const float rstd = rsqrtf(ss * (1.f / 128.f) + EPSF);
        const size_t obase = (tok0 + il) * 1024 + h * 128 + 64 * dvh + 4 * hi;
#pragma unroll
        for (int d = 0; d < 2; ++d)
#pragma unroll
            for (int g = 0; g < 4; ++g) {
                const u32x2 gw2 = *(const u32x2*)(GR + obase + 32 * d + 8 * g);
                const float g0 = bf_lo(gw2.x), g1 = bf_hi(gw2.x), g2 = bf_lo(gw2.y), g3 = bf_hi(gw2.y);
                u32x2 o;
                o.x = pkbf(g0 * pg8::sigm(g0) * acc[d][4 * g] * rstd, g1 * pg8::sigm(g1) * acc[d][4 * g + 1] * rstd);
                o.y = pkbf(g2 * pg8::sigm(g2) * acc[d][4 * g + 2] * rstd, g3 * pg8::sigm(g3) * acc[d][4 * g + 3] * rstd);
                *(u32x2*)(OB + obase + 32 * d + 8 * g) = o;
            }
        __syncthreads();
    }
#undef RO_LOAD
#undef RO_STORE
}

#define XB_TMO      128
#define XB_XCNT(j)  (256  + 64 * (j))
#define XB_XSUB(j)  (1280 + 64 * (j))
#define XB_XGEN(j)  (2304 + 64 * (j))
#define XB_TOP      3328
#define XB_TOPGEN   3392
#define XCD_BAR_WORDS 3456
#define XB_SPIN_CAP (1u << 18)

__device__ __forceinline__ unsigned xb_ld(unsigned* p)              { return __hip_atomic_load(p, __ATOMIC_RELAXED, __HIP_MEMORY_SCOPE_AGENT); }
__device__ __forceinline__ unsigned xb_add(unsigned* p, unsigned v) { return __hip_atomic_fetch_add(p, v, __ATOMIC_RELAXED, __HIP_MEMORY_SCOPE_AGENT); }
__device__ __forceinline__ unsigned xb_xcc_id() { return (unsigned)__builtin_amdgcn_s_getreg((3 << 11) | 20) & 0xFu; }
#define XB_SPIN(cond, bar) do { unsigned _sp = 0; while (cond) { __builtin_amdgcn_s_sleep(1); \
    if ((++_sp & 255u) == 0u) { if (xb_ld(&(bar)[XB_TMO])) break; if (_sp > XB_SPIN_CAP) { atomicAdd(&(bar)[XB_TMO], 1u); break; } } } } while (0)

struct XcdBarrier {
    unsigned* bar; unsigned x;
    volatile LAS unsigned* st;
};

__device__ __forceinline__ XcdBarrier xcd_barrier_post(unsigned* bar, volatile LAS unsigned* st) {
    XcdBarrier b; b.bar = bar; b.x = xb_xcc_id(); b.st = st;
    if (threadIdx.x == 0) (void)xb_add(&bar[XB_XCNT(b.x)], 1u);
    return b;
}
__device__ __forceinline__ void xcd_barrier_complete(unsigned* bar, unsigned x, unsigned& nloc, unsigned& nx) {
    const unsigned G = gridDim.x * gridDim.y * gridDim.z;
    unsigned sum, cnt, mine, sp = 0u;
    for (;;) {
        sum = 0u; cnt = 0u; mine = 0u;
#pragma unroll
        for (unsigned j = 0; j < 16; ++j) { const unsigned c = xb_ld(&bar[XB_XCNT(j)]); sum += c; cnt += (c > 0u) ? 1u : 0u; mine = (j == x) ? c : mine; }
        if (sum == G) break;
        __builtin_amdgcn_s_sleep(1);
        if ((++sp & 255u) == 0u) { if (xb_ld(&bar[XB_TMO])) break; if (sp > XB_SPIN_CAP) { atomicAdd(&bar[XB_TMO], 1u); break; } }
    }
    nloc = mine > 0u ? mine : 1u; nx = cnt > 0u ? cnt : 1u;
}

__device__ __forceinline__ void xcd_barrier(const XcdBarrier& b) {
    asm volatile("s_waitcnt vmcnt(0)" ::: "memory");
    __syncthreads();
    if (threadIdx.x == 0) {
        unsigned* bar = b.bar;
        __builtin_amdgcn_s_waitcnt(0);
        unsigned nloc = b.st[0], nx = b.st[1];
        if (nloc == 0u) { xcd_barrier_complete(bar, b.x, nloc, nx); b.st[0] = nloc; b.st[1] = nx; }
        const unsigned old = xb_add(&bar[XB_XSUB(b.x)], 1u);
        const unsigned gen = old / nloc;
        if (old + 1u == (gen + 1u) * nloc) {
            __builtin_amdgcn_fence(__ATOMIC_RELEASE, "agent");
            asm volatile("s_waitcnt vmcnt(0)" ::: "memory");
            const unsigned og = xb_add(&bar[XB_TOP], 1u);
            const unsigned tg = og / nx;
            if (og + 1u == (tg + 1u) * nx) xb_add(&bar[XB_TOPGEN], 1u);
            else XB_SPIN(xb_ld(&bar[XB_TOPGEN]) == tg, bar);
            __builtin_amdgcn_fence(__ATOMIC_ACQUIRE, "agent");
            xb_add(&bar[XB_XGEN(b.x)], 1u);
            asm volatile("s_waitcnt vmcnt(0)" ::: "memory");
        } else {
            XB_SPIN(xb_ld(&bar[XB_XGEN(b.x)]) == gen, bar);
            __builtin_amdgcn_fence(__ATOMIC_ACQUIRE, "agent");
            asm volatile("s_waitcnt vmcnt(0)" ::: "memory");
        }
    }
    __syncthreads();
}

__global__ void __launch_bounds__(NTHR, 2) fwd_kernel(Params P) {
    extern __shared__ __attribute__((aligned(16))) unsigned char lds_raw[];
    LAS unsigned char* lds = (LAS unsigned char*)lds_raw;
    cg::grid_group grid = cg::this_grid();
    const int G = gridDim.x, bid = blockIdx.x;
    volatile LAS unsigned* MISC = (volatile LAS unsigned*)(lds + 131072);
    unsigned* barw = (unsigned*)(P.ws + WS_BAR);
    if (threadIdx.x < 2) MISC[threadIdx.x] = 0u;
    __syncthreads();
    XcdBarrier bar = xcd_barrier_post(barw, MISC);
    if (P.ws == nullptr) grid.sync();
    const int wave_s = __builtin_amdgcn_readfirstlane((int)threadIdx.x >> 6);
#define TIDP() ({ int l_; asm volatile("v_mbcnt_lo_u32_b32 %0, -1, 0\n\tv_mbcnt_hi_u32_b32 %0, -1, %0" : "=v"(l_)); wave_s * 64 + l_; })
    unsigned char* ws = P.ws;
    bf16* XN = (bf16*)(ws + WS_XN);
    pg8::EpiProj EP; EP.t0 = 0; EP.ws = ws;

    p0_prologue(P, lds, TIDP(), G <= 128);
        xcd_barrier(bar);
    {
    { pg8::Gemm g{XN, (const bf16*)(ws + WS_WIN), MTOK, 512, 1024}; pg8::StaticOrder S; S.init(MTOK, 512, G, bid); EP.t0 = 0;
      pg8::gemm_phase<pg8::EpiProj, pg8::StaticOrder, true, true>(lds, g, S, EP, TIDP()); }
    if (G > 128 && bid >= 128) { const int t_ = TIDP(); p0_late_weights(P, lds, t_, (bid - 128) * NWAVES + (t_ >> 6), (G - 128) * NWAVES); }
    }
    xcd_barrier(bar);
    {
    { int Kq = 256; asm volatile("" : "+s"(Kq)); pg8::Gemm g{(const bf16*)(ws + WS_CQ), (const bf16*)(ws + WS_WQB), MTOK, 768, Kq}; pg8::StaticOrder S; S.init(MTOK, 768, G, bid); pg8::EpiBf16S E{(bf16*)(ws + WS_UQ), 768};
      pg8::gemm_phase<pg8::EpiBf16S, pg8::StaticOrder, true, true>(lds, g, S, E, TIDP()); }
    { int Kk = 128; asm volatile("" : "+s"(Kk)); pg8::Gemm g{(const bf16*)(ws + WS_CKV), (const bf16*)(ws + WS_WKVB), MTOK, 1024, Kk}; pg8::StaticOrder S; S.init(MTOK, 1024, G, bid); pg8::EpiBf16S E{(bf16*)(ws + WS_UKV), 1024};
      pg8::gemm_phase<pg8::EpiBf16S, pg8::StaticOrder, true, true>(lds, g, S, E, TIDP()); }
    }
    xcd_barrier(bar);
    mla_prep(P, TIDP());
    xcd_barrier(bar);
    bool nomax;
    { float gq = 0.f, gk = 0.f;
      for (int i = 0; i < 96; ++i) { gq = fmaxf(gq, fabsf(P.g_qn[i])); gk = fmaxf(gk, fabsf(P.g_kn[i])); }
      const float bound = 9.797958971f * LOG2E * gq * gk;
      nomax = __builtin_amdgcn_readfirstlane((bound < 100.f) ? 1 : 0) != 0; }
    for (int u = bid; u < 512; u += G) {
        const int bh = (u & 7) * 2 + (u >> 8), qb = (u >> 3) & 31;
        if (nomax) {
            if (wave_s < 4) attn_unit<false, true>(lds, (const bf16*)(ws + WS_AQ), (const bf16*)(ws + WS_AK), (const bf16*)(ws + WS_AV), (bf16*)(ws + WS_AO), bh, qb, TIDP());
            else attn_unit<true, true>(lds, (const bf16*)(ws + WS_AQ), (const bf16*)(ws + WS_AK), (const bf16*)(ws + WS_AV), (bf16*)(ws + WS_AO), bh, qb, TIDP());
        } else {
            if (wave_s < 4) attn_unit<false, false>(lds, (const bf16*)(ws + WS_AQ), (const bf16*)(ws + WS_AK), (const bf16*)(ws + WS_AV), (bf16*)(ws + WS_AO), bh, qb, TIDP());
            else attn_unit<true, false>(lds, (const bf16*)(ws + WS_AQ), (const bf16*)(ws + WS_AK), (const bf16*)(ws + WS_AV), (bf16*)(ws + WS_AO), bh, qb, TIDP());
        }
    }
    { pg8::Gemm g{XN, (const bf16*)(ws + WS_WIN) + (size_t)2 * 256 * 1024, MTOK, 3072, 1024}; pg8::StaticOrder S; S.init(MTOK, 3072, G, bid); EP.t0 = 2;
      pg8::gemm_phase<pg8::EpiProj, pg8::StaticOrder, true, true>(lds, g, S, EP, TIDP()); }
    xcd_barrier(bar);
    ret_local_lds(P, lds, TIDP());
    xcd_barrier(bar);
    ret_scan(P, TIDP());
    xcd_barrier(bar);
    ret_out_lds(P, lds, TIDP());
    xcd_barrier(bar);
    {
    { pg8::Gemm g{(const bf16*)(ws + WS_AO), (const bf16*)(ws + WS_WMLA), MTOK, 1024, 512}; pg8::StaticOrder S; S.init(MTOK, 1024, G, bid); pg8::EpiBf16S E{(bf16*)(ws + WS_YA), 1024};
      pg8::gemm_phase<pg8::EpiBf16S, pg8::StaticOrder, true, true>(lds, g, S, E, TIDP()); }
    { pg8::Gemm g{(const bf16*)(ws + WS_OB), (const bf16*)(ws + WS_WRET), MTOK, 1024, 1024}; pg8::StaticOrder S; S.init(MTOK, 1024, G, bid); pg8::EpiBf16S E{(bf16*)(ws + WS_YB), 1024};
      pg8::gemm_phase<pg8::EpiBf16S, pg8::StaticOrder, true, true>(lds, g, S, E, TIDP()); }
    }
    xcd_barrier(bar);
    {
    { pg8::Gemm g{XN, (const bf16*)(ws + WS_WIN) + (size_t)14 * 256 * 1024, MTOK, 2048, 1024}; pg8::StaticOrder S; S.init(MTOK, 2048, G, bid); EP.t0 = 14;
      pg8::gemm_phase<pg8::EpiProj, pg8::StaticOrder, true, true>(lds, g, S, EP, TIDP()); }
    }
    xcd_barrier(bar);
    {
    { pg8::Gemm g{(const bf16*)(ws + WS_MERGED), (const bf16*)(ws + WS_WOUT), MTOK, 1024, 1024}; pg8::StaticOrder S; S.init(MTOK, 1024, G, bid);
      pg8::EpiWout E{P.x, P.out, (bf16*)(ws + WS_X1B), (float*)(ws + WS_SSQP)};
      pg8::gemm_phase<pg8::EpiWout, pg8::StaticOrder, true, true>(lds, g, S, E, TIDP()); }
    }
    xcd_barrier(bar);
    { pg8::Gemm g{(const bf16*)(ws + WS_X1B), (const bf16*)(ws + WS_WGU), MTOK, 5632, 1024}; pg8::StaticOrder S; S.init(MTOK, 5632, G, bid);
      pg8::EpiGU E{(const float*)(ws + WS_SSQP), (bf16*)(ws + WS_HID)};
      pg8::gemm_phase<pg8::EpiGU, pg8::StaticOrder, true, true>(lds, g, S, E, TIDP()); }
    xcd_barrier(bar);
    { pg8::Gemm g{(const bf16*)(ws + WS_HID), (const bf16*)(ws + WS_WDN), MTOK, 1024, 2816}; pg8::StaticOrder S; S.init(MTOK, 1024, G, bid);
      pg8::EpiDown E{(const bf16*)(ws + WS_X1B), P.out};
      pg8::gemm_phase<pg8::EpiDown, pg8::StaticOrder, true, true>(lds, g, S, E, TIDP()); }
}

extern "C" void kernel_launch(void* const* d_in, const int* in_sizes, int n_in, void* d_out, int out_size, void* d_ws, size_t ws_size, hipStream_t stream) {
    static int grid = 0;
    if (grid == 0) {
        if (n_in != 18 || ws_size < WS_END) { fprintf(stderr, "kernel_launch: unexpected n_in %d / ws_size %zu (need %zu)\n", n_in, ws_size, (size_t)WS_END); grid = -1; return; }
        int dev = 0, cus = 0, per_cu = 0;
        hipGetDevice(&dev);
        hipDeviceGetAttribute(&cus, hipDeviceAttributeMultiprocessorCount, dev);
        if (hipFuncSetAttribute((const void*)fwd_kernel, hipFuncAttributeMaxDynamicSharedMemorySize, LDS_BYTES) != hipSuccess) fprintf(stderr, "kernel_launch: hipFuncSetAttribute failed\n");
        if (hipOccupancyMaxActiveBlocksPerMultiprocessor(&per_cu, (const void*)fwd_kernel, NTHR, LDS_BYTES) != hipSuccess || per_cu < 1) { fprintf(stderr, "kernel_launch: occupancy query gave %d\n", per_cu); per_cu = 1; }
        (void)hipGetLastError();
        grid = cus * per_cu;
    }
    if (grid < 0) return;
    Params p{};
    p.x = (const float*)d_in[0]; p.pos = (const int*)d_in[1]; p.g_mix = (const float*)d_in[2]; p.w_in = (const float*)d_in[3]; p.g_q_a = (const float*)d_in[4]; p.w_q_b = (const float*)d_in[5];
    p.g_kv_a = (const float*)d_in[6]; p.w_kv_b = (const float*)d_in[7]; p.g_qn = (const float*)d_in[8]; p.g_kn = (const float*)d_in[9]; p.w_mla_out = (const float*)d_in[10];
    p.dec_f = (const float*)d_in[11]; p.dec_b = (const float*)d_in[12]; p.w_ret_out = (const float*)d_in[13]; p.w_out = (const float*)d_in[14]; p.g_ffn = (const float*)d_in[15];
    p.w_gate_up = (const float*)d_in[16]; p.w_down = (const float*)d_in[17];
    p.out = (float*)d_out; p.ws = (unsigned char*)d_ws;
    if (hipMemsetAsync((unsigned char*)d_ws + WS_BAR, 0, 16384, stream) != hipSuccess) { fprintf(stderr, "kernel_launch: hipMemsetAsync failed\n"); return; }
    void* args[] = {&p};
    hipError_t e = hipLaunchCooperativeKernel((const void*)fwd_kernel, dim3(grid), dim3(NTHR), args, LDS_BYTES, stream);
    if (e != hipSuccess) fprintf(stderr, "kernel_launch: cooperative launch failed: %s (grid %d)\n", hipGetErrorString(e), grid);
}
```

```cpp
#include <hip/hip_runtime.h>
#include <hip/hip_cooperative_groups.h>
#include <cstdio>
#include <cstdint>
namespace cg = cooperative_groups;
#include <cstddef>
constexpr size_t MiB = 1u << 20;
constexpr size_t WS_WIN = 0, WS_WGU = 11 * MiB, WS_WDN = 22 * MiB, WS_WRET = 27 * MiB + 512 * 1024, WS_WOUT = 29 * MiB + 512 * 1024, WS_WMLA = 31 * MiB + 512 * 1024,
                 WS_WQB = 32 * MiB + 512 * 1024, WS_WKVB = 33 * MiB;
constexpr size_t WS_COSR = 34 * MiB, WS_SINR = 36 * MiB, WS_COSA = 38 * MiB, WS_SINA = 39 * MiB, WS_SSQP = 40 * MiB;
constexpr size_t WS_XN = 41 * MiB;
constexpr size_t WS_CQ = 73 * MiB, WS_CKV = 81 * MiB, WS_KROPE = 85 * MiB, WS_UQ = 86 * MiB, WS_UKV = 110 * MiB, WS_AQ = 142 * MiB, WS_AK = 166 * MiB, WS_AV = 190 * MiB, WS_AO = 206 * MiB;
constexpr size_t WS_RQ = 73 * MiB, WS_RK = 89 * MiB, WS_VR = 105 * MiB, WS_GR = 222 * MiB, WS_LT = 169 * MiB, WS_OB = 137 * MiB;
constexpr size_t WS_YB = 73 * MiB, WS_YA = 169 * MiB, WS_MERGED = 222 * MiB, WS_X1B = 73 * MiB, WS_HID = 105 * MiB;
constexpr int VT_PITCH = 16384 + 64;
constexpr size_t WS_RSTD = 254 * MiB + 16384;
constexpr size_t WS_BAR = 254 * MiB;
constexpr size_t WS_END = 254 * MiB + 16384 + 65536;

namespace pg8 {
#define PG8_LAS __attribute__((address_space(3)))
typedef unsigned short bf16_t;
typedef short bf16x8 __attribute__((ext_vector_type(8)));
typedef float f32x4 __attribute__((ext_vector_type(4)));
typedef unsigned u32x4 __attribute__((ext_vector_type(4)));
constexpr int BM = 256, BK = 64, HALF = 128, HTB = HALF * BK * 2  , STAGE_BYTES = 8 * HTB, NXCD = 8, WGM = 4;

__host__ __device__ __forceinline__ int lds_byte(int r, int c) { const int st = (r >> 4) * 2 + (c >> 5), rr = r & 15, cc = c & 31, ob = rr * 64 + cc * 2; return st * 1024 + (ob ^ (((ob >> 9) & 1) << 5)); }
__host__ __device__ __forceinline__ void stage_rc(int b, int& R, int& C) { const int st = b / 1024, sb = b % 1024, swz = sb ^ (((sb >> 9) & 1) << 5); R = (st >> 1) * 16 + swz / 64; C = (st & 1) * 32 + (swz % 64) / 2; }
__host__ __device__ __forceinline__ int perm32(int rho) { const int n = rho >> 4, i = rho & 15; return 8 * (i >> 2) + 4 * n + (i & 3); }

struct Unit { int pm, pn; };
struct Gemm { const bf16_t* A; const bf16_t* Bt; int M, N, K; };

struct StaticOrder {
    int nM, nN, nwg, G, c;
    __host__ __device__ void init(int M, int N, int G_, int c_) { nM = M / BM; nN = N / BM; nwg = nM * nN; G = G_; c = c_; }
    __host__ __device__ bool next(int i, Unit& u) const {
        const long L = (long)i * G + c; if (L >= nwg) return false;
        int wgid = (int)L; { const int q = nwg / NXCD, r = nwg % NXCD, xcd = wgid % NXCD, off = wgid / NXCD; wgid = (xcd < r ? xcd * (q + 1) : r * (q + 1) + (xcd - r) * q) + off; }
        const int nig = WGM * nN, gid = wgid / nig, fm = gid * WGM, gsz = (nM - fm) < WGM ? (nM - fm) : WGM;
        u.pm = fm + ((wgid % nig) % gsz); u.pn = (wgid % nig) / gsz; return true;
    }
    __device__ __forceinline__ void a_ready(const Unit&) const {}
    __device__ __forceinline__ void done(const Unit&) const {}
};

__device__ __forceinline__ unsigned cvt_pk_bf16(float lo, float hi) { unsigned r; asm volatile("v_cvt_pk_bf16_f32 %0, %1, %2" : "=v"(r) : "v"(lo), "v"(hi)); return r; }
typedef float f32x2 __attribute__((ext_vector_type(2)));
typedef unsigned u32x2 __attribute__((ext_vector_type(2)));
typedef float f32x2 __attribute__((ext_vector_type(2)));
typedef __bf16 bf16x2_t __attribute__((ext_vector_type(2)));
__device__ __forceinline__ unsigned pkbf(float lo, float hi) { f32x2 v = {lo, hi}; bf16x2_t b = __builtin_convertvector(v, bf16x2_t); return __builtin_bit_cast(unsigned, b); }
__device__ __forceinline__ float bf_lo(unsigned w) { return __uint_as_float(w << 16); }
__device__ __forceinline__ float bf_hi(unsigned w) { return __uint_as_float(w & 0xffff0000u); }
__device__ __forceinline__ float sigm(float x) { return __builtin_amdgcn_rcpf(1.f + __expf(-x)); }
__device__ __forceinline__ u32x4 pk8(const f32x4 a, const f32x4 b) { u32x4 w; w.x = pkbf(a[0], a[1]); w.y = pkbf(a[2], a[3]); w.z = pkbf(b[0], b[1]); w.w = pkbf(b[2], b[3]); return w; }

template <int X> __device__ __forceinline__ float shx(float v) { return __int_as_float(__builtin_amdgcn_ds_swizzle(__float_as_int(v), (X << 10) | 0x1f)); }
__device__ __forceinline__ float add_x32(float v) { auto rr = __builtin_amdgcn_permlane32_swap(__float_as_uint(v), __float_as_uint(v), false, false); return __uint_as_float(rr[0]) + __uint_as_float(rr[1]); }
__device__ __forceinline__ float max_x32(float v) { auto rr = __builtin_amdgcn_permlane32_swap(__float_as_uint(v), __float_as_uint(v), false, false); return fmaxf(__uint_as_float(rr[0]), __uint_as_float(rr[1])); }

struct EpiProj {
    static constexpr bool PERM = true, AFTER_DRAIN = false;
    int t0; unsigned char* ws;
    __device__ __forceinline__ void operator()(const f32x4 (&acc)[2][2][4][2], const Unit& u, int wr, int wc, int fr, int fq) const {
        const int t = t0 + u.pn;
        const int row0 = u.pm * BM + wr * 64 + fr;
        if (t >= 2 && t < 6) {
            const bool isk = t >= 4; bf16_t* O = (bf16_t*)(ws + (isk ? WS_RK : WS_RQ)); const float sc = isk ? 0.125f : 1.f;
            const float* cosR = (const float*)(ws + WS_COSR); const float* sinR = (const float*)(ws + WS_SINR);
            const int head = 4 * (t & 1) + wc, dl0 = 8 * fq;
#pragma unroll
            for (int ai = 0; ai < 2; ++ai)
#pragma unroll
              for (int mp = 0; mp < 2; ++mp) {
                f32x4 cc[2][2], sn_[2][2];
#pragma unroll
                for (int mm = 0; mm < 2; ++mm) { const size_t ro = (size_t)(row0 + ai * HALF + (2 * mp + mm) * 16) * 32 + dl0;
                    cc[mm][0] = *(const f32x4*)(cosR + ro); cc[mm][1] = *(const f32x4*)(cosR + ro + 4); sn_[mm][0] = *(const f32x4*)(sinR + ro); sn_[mm][1] = *(const f32x4*)(sinR + ro + 4); }
#pragma unroll
                for (int mm = 0; mm < 2; ++mm) {
                    const int m = 2 * mp + mm;
                    const int row = row0 + ai * HALF + m * 16;
                    const f32x4 c0 = cc[mm][0], c1 = cc[mm][1], s0 = sn_[mm][0], s1 = sn_[mm][1];
                    const f32x4 x1a = acc[ai][0][m][0], x1b = acc[ai][0][m][1], x2a = acc[ai][1][m][0], x2b = acc[ai][1][m][1];
                    const f32x4 o1a = (x1a * c0 - x2a * s0) * sc, o1b = (x1b * c1 - x2b * s1) * sc;
                    const f32x4 o2a = (x2a * c0 + x1a * s0) * sc, o2b = (x2b * c1 + x1b * s1) * sc;
                    bf16_t* p = O + (size_t)row * 512 + head * 64 + dl0;
                    *(u32x4*)p = pk8(o1a, o1b); *(u32x4*)(p + 32) = pk8(o2a, o2b);
                }
                asm volatile("" ::: "memory");
              }
        } else if (t >= 14) {
            const bf16_t* YA = (const bf16_t*)(ws + WS_YA); const bf16_t* YB = (const bf16_t*)(ws + WS_YB); bf16_t* MG = (bf16_t*)(ws + WS_MERGED);
            const int col = 128 * (t - 14) + 32 * wc + 8 * fq;
#pragma unroll
            for (int ai = 0; ai < 2; ++ai) {
                u32x4 yav[4], ybv[4];
#pragma unroll
                for (int m = 0; m < 4; ++m) { const size_t off = (size_t)(row0 + ai * HALF + m * 16) * 1024 + col; yav[m] = *(const u32x4*)(YA + off); ybv[m] = *(const u32x4*)(YB + off); }
#pragma unroll
                for (int m = 0; m < 4; ++m) {
                    const size_t off = (size_t)(row0 + ai * HALF + m * 16) * 1024 + col;
                    const u32x4 ya = yav[m], yb = ybv[m];
                    const f32x4 la0 = acc[ai][0][m][0], la1 = acc[ai][0][m][1], lb0 = acc[ai][1][m][0], lb1 = acc[ai][1][m][1];
                    f32x4 r0, r1;
                    r0[0] = sigm(la0[0]) * bf_lo(ya.x) + sigm(lb0[0]) * bf_lo(yb.x); r0[1] = sigm(la0[1]) * bf_hi(ya.x) + sigm(lb0[1]) * bf_hi(yb.x);
                    r0[2] = sigm(la0[2]) * bf_lo(ya.y) + sigm(lb0[2]) * bf_lo(yb.y); r0[3] = sigm(la0[3]) * bf_hi(ya.y) + sigm(lb0[3]) * bf_hi(yb.y);
                    r1[0] = sigm(la1[0]) * bf_lo(ya.z) + sigm(lb1[0]) * bf_lo(yb.z); r1[1] = sigm(la1[1]) * bf_hi(ya.z) + sigm(lb1[1]) * bf_hi(yb.z);
                    r1[2] = sigm(la1[2]) * bf_lo(ya.w) + sigm(lb1[2]) * bf_lo(yb.w); r1[3] = sigm(la1[3]) * bf_hi(ya.w) + sigm(lb1[3]) * bf_hi(yb.w);
                    *(u32x4*)(MG + off) = pk8(r0, r1);
                }
                asm volatile("" ::: "memory");
            }
        } else {
#pragma unroll
            for (int bj = 0; bj < 2; ++bj) {
                size_t wo; int ld, col; bool on = true;
                if (t == 0) { wo = WS_CQ; ld = 256; col = 128 * bj; }
                else if (t == 1) { if (bj == 0) { wo = WS_CKV; ld = 128; col = 0; } else { wo = WS_KROPE; ld = 32; col = 0; on = (wc == 0); } }
                else if (t < 10) { wo = WS_VR; ld = 1024; col = 256 * (t - 6) + 128 * bj; }
                else if (t < 14) { wo = WS_GR; ld = 1024; col = 256 * (t - 10) + 128 * bj; }
                else { wo = WS_GR; ld = 1024; col = 256 * ((t - 10) & 3) + 128 * bj; }
                bf16_t* O = (bf16_t*)(ws + wo);
                col += 32 * wc + 8 * fq;
                if (on) {
#pragma unroll
                    for (int ai = 0; ai < 2; ++ai)
#pragma unroll
                        for (int m = 0; m < 4; ++m) {
                            const int row = row0 + ai * HALF + m * 16;
                            *(u32x4*)(O + (size_t)row * ld + col) = pk8(acc[ai][bj][m][0], acc[ai][bj][m][1]);
                        }
                }
            }
        }
    }
};
struct EpiBf16S {
    static constexpr bool PERM = true, AFTER_DRAIN = false;
    bf16_t* O; int ldc;
    __device__ __forceinline__ void operator()(const f32x4 (&acc)[2][2][4][2], const Unit& u, int wr, int wc, int fr, int fq) const {
        const int row0 = u.pm * BM + wr * 64 + fr, col0 = u.pn * BM + 32 * wc + 8 * fq;
#pragma unroll
        for (int ai = 0; ai < 2; ++ai)
#pragma unroll
            for (int m = 0; m < 4; ++m)
#pragma unroll
                for (int bj = 0; bj < 2; ++bj)
                    *(u32x4*)(O + (size_t)(row0 + ai * HALF + m * 16) * ldc + col0 + bj * HALF) = pk8(acc[ai][bj][m][0], acc[ai][bj][m][1]);
    }
};
struct EpiGate {
    static constexpr bool PERM = true, AFTER_DRAIN = false;
    const bf16_t* GL; bf16_t* PART; bf16_t* MERGED; int second;
    __device__ __forceinline__ void operator()(const f32x4 (&acc)[2][2][4][2], const Unit& u, int wr, int wc, int fr, int fq) const {
        const int row0 = u.pm * BM + wr * 64 + fr, col0 = u.pn * BM + 32 * wc + 8 * fq;
#pragma unroll
        for (int ai = 0; ai < 2; ++ai)
#pragma unroll
            for (int m = 0; m < 4; ++m)
#pragma unroll
                for (int bj = 0; bj < 2; ++bj) {
                    const int row = row0 + ai * HALF + m * 16, col = col0 + bj * HALF;
                    const u32x4 g = *(const u32x4*)(GL + (size_t)row * 2048 + second * 1024 + col);
                    const f32x4 a = acc[ai][bj][m][0], b = acc[ai][bj][m][1];
                    f32x4 ra, rb;
                    ra[0] = sigm(bf_lo(g.x)) * a[0]; ra[1] = sigm(bf_hi(g.x)) * a[1]; ra[2] = sigm(bf_lo(g.y)) * a[2]; ra[3] = sigm(bf_hi(g.y)) * a[3];
                    rb[0] = sigm(bf_lo(g.z)) * b[0]; rb[1] = sigm(bf_hi(g.z)) * b[1]; rb[2] = sigm(bf_lo(g.w)) * b[2]; rb[3] = sigm(bf_hi(g.w)) * b[3];
                    if (second) {
                        const u32x4 p = *(const u32x4*)(PART + (size_t)row * 1024 + col);
                        ra[0] += bf_lo(p.x); ra[1] += bf_hi(p.x); ra[2] += bf_lo(p.y); ra[3] += bf_hi(p.y);
                        rb[0] += bf_lo(p.z); rb[1] += bf_hi(p.z); rb[2] += bf_lo(p.w); rb[3] += bf_hi(p.w);
                        *(u32x4*)(MERGED + (size_t)row * 1024 + col) = pk8(ra, rb);
                    } else {
                        *(u32x4*)(PART + (size_t)row * 1024 + col) = pk8(ra, rb);
                    }
                    asm volatile("" ::: "memory");
                }
    }
};
struct EpiWout {
    static constexpr bool PERM = false, AFTER_DRAIN = false;
    const float* X; float* X1; bf16_t* X1B; float* SSQP;
    __device__ __forceinline__ void operator()(const f32x4 (&acc)[2][2][4][2], const Unit& u, int wr, int wc, int fr, int fq) const {
        const int row0 = u.pm * BM + wr * 64 + fr, col0 = u.pn * BM + 32 * wc + 4 * fq;
#pragma unroll
        for (int ai = 0; ai < 2; ++ai)
#pragma unroll
            for (int mp = 0; mp < 2; ++mp) {
                f32x4 xv[2][2][2];
#pragma unroll
                for (int mm = 0; mm < 2; ++mm)
#pragma unroll
                    for (int bj = 0; bj < 2; ++bj)
#pragma unroll
                        for (int n = 0; n < 2; ++n) xv[mm][bj][n] = __builtin_nontemporal_load((const f32x4*)(X + (size_t)(row0 + ai * HALF + (2 * mp + mm) * 16) * 1024 + col0 + bj * HALF + n * 16));
#pragma unroll
                for (int mm = 0; mm < 2; ++mm) {
                    const int m = 2 * mp + mm, row = row0 + ai * HALF + m * 16; float ss = 0.f;
#pragma unroll
                    for (int bj = 0; bj < 2; ++bj)
#pragma unroll
                        for (int n = 0; n < 2; ++n) {
                            const size_t off = (size_t)row * 1024 + col0 + bj * HALF + n * 16;
                            const f32x4 o = xv[mm][bj][n] + acc[ai][bj][m][n];
                            u32x2 w; w.x = pkbf(o[0], o[1]); w.y = pkbf(o[2], o[3]); *(u32x2*)(X1B + off) = w;
                            ss += (o[0] * o[0] + o[1] * o[1]) + (o[2] * o[2] + o[3] * o[3]);
                        }
                    ss += shx<16>(ss); ss = add_x32(ss);
                    if (fq == 0) SSQP[(size_t)row * 16 + 4 * u.pn + wc] = ss;
                }
                asm volatile("" ::: "memory");
            }
    }
};
struct EpiGU {
    static constexpr bool PERM = true, AFTER_DRAIN = false;
    const float* SSQP; bf16_t* HID;
    __device__ __forceinline__ void operator()(const f32x4 (&acc)[2][2][4][2], const Unit& u, int wr, int wc, int fr, int fq) const {
        const int row0 = u.pm * BM + wr * 64 + fr, col0 = u.pn * HALF + 32 * wc + 8 * fq;
#pragma unroll
        for (int ai = 0; ai < 2; ++ai)
#pragma unroll
            for (int m = 0; m < 4; ++m) {
                const int row = row0 + ai * HALF + m * 16;
                const f32x4* sp = (const f32x4*)(SSQP + (size_t)row * 16);
                const f32x4 q0 = sp[0], q1 = sp[1], q2 = sp[2], q3 = sp[3];
                const f32x4 qs = (q0 + q1) + (q2 + q3);
                const float rstd = rsqrtf(((qs[0] + qs[1]) + (qs[2] + qs[3])) * (1.0f / 1024.0f) + 1e-6f);
                f32x4 h[2];
#pragma unroll
                for (int n = 0; n < 2; ++n)
#pragma unroll
                    for (int e = 0; e < 4; ++e) { const float g = acc[ai][0][m][n][e] * rstd, up = acc[ai][1][m][n][e] * rstd; h[n][e] = g * sigm(g) * up; }
                __builtin_nontemporal_store(pk8(h[0], h[1]), (u32x4*)(HID + (size_t)row * 2816 + col0));
                asm volatile("" ::: "memory");
            }
    }
};
struct EpiDown {
    static constexpr bool PERM = false, AFTER_DRAIN = false;
    const bf16_t* X1B; float* OUT;
    __device__ __forceinline__ void operator()(const f32x4 (&acc)[2][2][4][2], const Unit& u, int wr, int wc, int fr, int fq) const {
        const int row0 = u.pm * BM + wr * 64 + fr, col0 = u.pn * BM + 32 * wc + 4 * fq;
#pragma unroll
        for (int ai = 0; ai < 2; ++ai) {
            u32x2 xb[4][2][2];
#pragma unroll
            for (int m = 0; m < 4; ++m)
#pragma unroll
                for (int bj = 0; bj < 2; ++bj)
#pragma unroll
                    for (int n = 0; n < 2; ++n) xb[m][bj][n] = *(const u32x2*)(X1B + (size_t)(row0 + ai * HALF + m * 16) * 1024 + col0 + bj * HALF + n * 16);
#pragma unroll
            for (int m = 0; m < 4; ++m)
#pragma unroll
                for (int bj = 0; bj < 2; ++bj)
#pragma unroll
                    for (int n = 0; n < 2; ++n) {
                        const size_t off = (size_t)(row0 + ai * HALF + m * 16) * 1024 + col0 + bj * HALF + n * 16;
                        f32x4 xv; xv[0] = bf_lo(xb[m][bj][n].x); xv[1] = bf_hi(xb[m][bj][n].x); xv[2] = bf_lo(xb[m][bj][n].y); xv[3] = bf_hi(xb[m][bj][n].y);
                        __builtin_nontemporal_store(xv + acc[ai][bj][m][n], (f32x4*)(OUT + off));
                    }
            asm volatile("" ::: "memory");
        }
    }
};
template <class Epi, class Sched, bool ALIGN_EPI = false, bool SP2 = false>
__device__ __forceinline__ void gemm_phase(PG8_LAS unsigned char* lds, const Gemm g, const Sched& S, const Epi& E, int tid_in) {
    int tid_ = tid_in; asm volatile("" : "+v"(tid_));
    const int tid = tid_, wid = __builtin_amdgcn_readfirstlane(tid >> 6), lane = tid & 63, wr = wid >> 2, wc = wid & 3, fr = lane & 15, fq = lane >> 4;
    const int K = g.K, nt = K / BK;
    unsigned voffA[2], voffB[2];
#pragma unroll
    for (int i = 0; i < 2; ++i) { int R, C; stage_rc(tid * 16 + i * 8192, R, C); const int Rb = Epi::PERM ? ((R & ~31) + perm32(R & 31)) : R;
        voffA[i] = (unsigned)(R * K + C) * 2u; voffB[i] = (unsigned)(Rb * K + C) * 2u; }
    const size_t kstep = (size_t)(BK * 2);
    const size_t hstep = (size_t)HALF * K * 2;
    const size_t tstep = 2 * hstep;
    const unsigned ldsw = (unsigned)wid * 1024u;
    const int aoff = lds_byte(wr * 64 + fr, fq * 8), boff = lds_byte(wc * 32 + fr, fq * 8);
#define PG8_SA(b, h) (((b) * 2 + (h)) * HTB)
#define PG8_SB(b, h) ((4 + (b) * 2 + (h)) * HTB)
#define PG8_STAGE(bufoff, gbase, voff) do { _Pragma("unroll") for (int _i = 0; _i < 2; ++_i) \
        __builtin_amdgcn_global_load_lds((const unsigned*)((const char*)(gbase) + (voff)[_i]), (PG8_LAS unsigned*)(lds + (bufoff) + ldsw + _i * 8192), 16, 0, 0); } while (0)
#define PG8_LDA(dst, b, h) do { _Pragma("unroll") for (int m = 0; m < 4; ++m) _Pragma("unroll") for (int k = 0; k < 2; ++k) dst[m][k] = *(const PG8_LAS bf16x8*)(lds + PG8_SA(b, h) + aoff + m * 2048 + k * 1024); } while (0)
#define PG8_LDB(dst, b, h) do { _Pragma("unroll") for (int n = 0; n < 2; ++n) _Pragma("unroll") for (int k = 0; k < 2; ++k) dst[n][k] = *(const PG8_LAS bf16x8*)(lds + PG8_SB(b, h) + boff + n * 2048 + k * 1024); } while (0)
#define PG8_MMA(ai, bj, At, Bt) do { __builtin_amdgcn_s_setprio(1); _Pragma("unroll") for (int m = 0; m < 4; ++m) _Pragma("unroll") for (int n = 0; n < 2; ++n) _Pragma("unroll") for (int k = 0; k < 2; ++k) \
        acc[ai][bj][m][n] = __builtin_amdgcn_mfma_f32_16x16x32_bf16(Bt[n][k], At[m][k], acc[ai][bj][m][n], 0, 0, 0); __builtin_amdgcn_s_setprio(0); } while (0)
#define PG8_WAIT_V(n) asm volatile("s_waitcnt vmcnt(" #n ")" ::: "memory")
#define PG8_WAIT_L(n) asm volatile("s_waitcnt lgkmcnt(" #n ")" ::: "memory")
#define PG8_BAR __builtin_amdgcn_s_barrier()
#define PG8_SCHED __builtin_amdgcn_sched_barrier(0)
    Unit cur, nxt; int ui = 0;
    if (!S.next(0, cur)) return;
    f32x4 acc[2][2][4][2];
#pragma unroll
    for (int a = 0; a < 2; ++a)
#pragma unroll
        for (int b = 0; b < 2; ++b)
#pragma unroll
            for (int m = 0; m < 4; ++m)
#pragma unroll
                for (int n = 0; n < 2; ++n) acc[a][b][m][n] = (f32x4){0.f, 0.f, 0.f, 0.f};
    bf16x8 At[4][2], B0[2][2], B1[2][2];
    const char* cA = (const char*)g.A + (size_t)cur.pm * tstep; const char* cB = (const char*)g.Bt + (size_t)cur.pn * tstep;
    S.a_ready(cur);
    if constexpr (SP2) {
        PG8_STAGE(PG8_SB(0, 0), cB, voffB); PG8_STAGE(PG8_SB(0, 1), cB + hstep, voffB); PG8_STAGE(PG8_SA(0, 0), cA, voffA); PG8_STAGE(PG8_SA(0, 1), cA + hstep, voffA);
        if (wr == 1) PG8_BAR;
        PG8_WAIT_V(2); PG8_BAR;
        PG8_STAGE(PG8_SB(1, 0), cB + kstep, voffB); PG8_STAGE(PG8_SA(1, 0), cA + kstep, voffA); PG8_STAGE(PG8_SB(1, 1), cB + hstep + kstep, voffB);
        PG8_WAIT_V(6); PG8_BAR;
    } else {
        PG8_STAGE(PG8_SB(0, 0), cB, voffB); PG8_STAGE(PG8_SA(0, 0), cA, voffA); PG8_STAGE(PG8_SB(0, 1), cB + hstep, voffB); PG8_STAGE(PG8_SA(0, 1), cA + hstep, voffA);
        if (wr == 1) PG8_BAR;
        PG8_WAIT_V(4); PG8_BAR;
        PG8_STAGE(PG8_SB(1, 0), cB + kstep, voffB); PG8_STAGE(PG8_SA(1, 0), cA + kstep, voffA); PG8_STAGE(PG8_SB(1, 1), cB + hstep + kstep, voffB);
        PG8_WAIT_V(6); PG8_BAR;
    }
    for (;;) {
        const bool has_next = S.next(ui + 1, nxt);
        const char* nA = has_next ? (const char*)g.A + (size_t)nxt.pm * tstep : cA; const char* nB = has_next ? (const char*)g.Bt + (size_t)nxt.pn * tstep : cB;
        for (int t = 0; t < nt; t += 2) {
            const bool last = (t == nt - 2);
            const char* a1 = cA + (size_t)(t + 1) * kstep;
            const char* a2 = last ? nA : cA + (size_t)(t + 2) * kstep; const char* b2 = last ? nB : cB + (size_t)(t + 2) * kstep;
            const char* a3 = a2 + kstep; const char* b3 = b2 + kstep;
            if (last && has_next) S.a_ready(nxt);
            if constexpr (SP2) {
            PG8_LDB(B0, 0, 0); PG8_LDB(B1, 0, 1); PG8_SCHED; PG8_LDA(At, 0, 0); PG8_STAGE(PG8_SA(1, 1), a1 + hstep, voffA);
            PG8_WAIT_V(8); PG8_WAIT_L(0); PG8_BAR; PG8_MMA(0, 0, At, B0); PG8_MMA(0, 1, At, B1); PG8_BAR; PG8_SCHED;
            PG8_LDA(At, 0, 1); PG8_STAGE(PG8_SB(0, 0), b2, voffB); PG8_STAGE(PG8_SB(0, 1), b2 + hstep, voffB); PG8_STAGE(PG8_SA(0, 0), a2, voffA);
            PG8_WAIT_V(8); PG8_WAIT_L(0); PG8_BAR; PG8_MMA(1, 0, At, B0); PG8_MMA(1, 1, At, B1); PG8_BAR; PG8_SCHED;
            PG8_LDB(B0, 1, 0); PG8_LDB(B1, 1, 1); PG8_SCHED; PG8_LDA(At, 1, 0); PG8_STAGE(PG8_SA(0, 1), a2 + hstep, voffA);
            PG8_WAIT_V(8); PG8_WAIT_L(0); PG8_BAR; PG8_MMA(0, 0, At, B0); PG8_MMA(0, 1, At, B1); PG8_BAR; PG8_SCHED;
            PG8_LDA(At, 1, 1); PG8_STAGE(PG8_SB(1, 0), b3, voffB); PG8_STAGE(PG8_SB(1, 1), b3 + hstep, voffB); PG8_STAGE(PG8_SA(1, 0), a3, voffA);
            PG8_WAIT_V(8); PG8_WAIT_L(0); PG8_BAR; PG8_MMA(1, 0, At, B0); PG8_MMA(1, 1, At, B1); PG8_BAR; PG8_SCHED;
            } else {
            PG8_LDB(B0, 0, 0); PG8_SCHED; PG8_LDA(At, 0, 0); PG8_STAGE(PG8_SA(1, 1), a1 + hstep, voffA);
            PG8_WAIT_L(8); PG8_BAR; PG8_WAIT_L(0); PG8_MMA(0, 0, At, B0); PG8_BAR; PG8_SCHED;
            PG8_LDB(B1, 0, 1); PG8_STAGE(PG8_SB(0, 0), b2, voffB);
            PG8_BAR; PG8_WAIT_L(0); PG8_MMA(0, 1, At, B1); PG8_BAR;
            PG8_LDA(At, 0, 1); PG8_STAGE(PG8_SA(0, 0), a2, voffA);
            PG8_BAR; PG8_WAIT_L(0); PG8_MMA(1, 0, At, B0); PG8_BAR; PG8_SCHED;
            PG8_STAGE(PG8_SB(0, 1), b2 + hstep, voffB);
            PG8_WAIT_V(6); PG8_BAR; PG8_MMA(1, 1, At, B1); PG8_BAR;
            PG8_LDB(B0, 1, 0); PG8_SCHED; PG8_LDA(At, 1, 0); PG8_STAGE(PG8_SA(0, 1), a2 + hstep, voffA);
            PG8_WAIT_L(8); PG8_BAR; PG8_WAIT_L(0); PG8_MMA(0, 0, At, B0); PG8_BAR; PG8_SCHED;
            PG8_LDB(B1, 1, 1); PG8_STAGE(PG8_SB(1, 0), b3, voffB);
            PG8_BAR; PG8_WAIT_L(0); PG8_MMA(0, 1, At, B1); PG8_BAR;
            PG8_LDA(At, 1, 1); PG8_STAGE(PG8_SA(1, 0), a3, voffA);
            PG8_BAR; PG8_WAIT_L(0); PG8_MMA(1, 0, At, B0); PG8_BAR; PG8_SCHED;
            PG8_STAGE(PG8_SB(1, 1), b3 + hstep, voffB);
            PG8_WAIT_V(6); PG8_BAR; PG8_MMA(1, 1, At, B1); PG8_BAR;
            }
        }
        if constexpr (ALIGN_EPI) { if (wr == 0) PG8_BAR; }
        if constexpr (!Epi::AFTER_DRAIN) { E(acc, cur, wr, wc, fr, fq); S.done(cur); }
        if (!has_next) break;
#pragma unroll
        for (int a = 0; a < 2; ++a)
#pragma unroll
            for (int b = 0; b < 2; ++b)
#pragma unroll
                for (int m = 0; m < 4; ++m)
#pragma unroll
                    for (int n = 0; n < 2; ++n) acc[a][b][m][n] = (f32x4){0.f, 0.f, 0.f, 0.f};
        cur = nxt; cA = nA; cB = nB; ++ui;
        if constexpr (ALIGN_EPI) { if (wr == 1) PG8_BAR; }
    }
    PG8_WAIT_V(0);
    if constexpr (!ALIGN_EPI) { if (wr == 0) PG8_BAR; }
    PG8_BAR;
    if constexpr (Epi::AFTER_DRAIN) { E.fused(acc, cur, wr, wc, fr, fq, lds, wid, lane); S.done(cur); }
#undef PG8_SA
#undef PG8_SB
#undef PG8_STAGE
#undef PG8_LDA
#undef PG8_LDB
#undef PG8_MMA
#undef PG8_WAIT_V
#undef PG8_WAIT_L
#undef PG8_BAR
#undef PG8_SCHED
}
}
#define LAS __attribute__((address_space(3)))
typedef unsigned short bf16;
typedef unsigned u32x4 __attribute__((ext_vector_type(4)));
typedef unsigned u32x2 __attribute__((ext_vector_type(2)));
typedef float f32x4 __attribute__((ext_vector_type(4)));
typedef float f32x16 __attribute__((ext_vector_type(16)));
typedef short bf16x8 __attribute__((ext_vector_type(8)));
using pg8::pkbf; using pg8::bf_lo; using pg8::bf_hi; using pg8::shx; using pg8::add_x32; using pg8::max_x32;

constexpr int NWAVES = 8, NTHR = 512;
constexpr int MTOK = 16384, SEQL = 8192, DM = 1024;
constexpr float EPSF = 1e-6f, LOG2E = 1.4426950408889634f;
constexpr float QSCALE = 0.10206207261596577f * 1.4426950408889634f;
constexpr int LDS_BYTES = 131072 + 256;

struct Params {
    const float* x; const int* pos; const float *g_mix, *w_in, *g_q_a, *w_q_b, *g_kv_a, *w_kv_b, *g_qn, *g_kn, *w_mla_out, *dec_f, *dec_b, *w_ret_out, *w_out, *g_ffn, *w_gate_up, *w_down;
    float* out; unsigned char* ws;
};

__device__ __forceinline__ int crow(int r, int hi) { return (r & 3) + 8 * (r >> 2) + 4 * hi; }
__device__ __forceinline__ float ex2(float x) { return __builtin_amdgcn_exp2f(x); }
#define MFMA32(a, b, c) __builtin_amdgcn_mfma_f32_32x32x16_bf16((a), (b), (c), 0, 0, 0)
#define LDS_WAIT() asm volatile("s_waitcnt lgkmcnt(0)" ::: "memory")

__device__ __forceinline__ void cvt_item(const float* __restrict__ W, int N, bf16* WT, int K, int k0, int n0, int drow0, const float* gk, LAS float* scr, int lane) {
    float v[32];
#pragma unroll
    for (int i = 0; i < 32; ++i) { const int kk = 2 * i + (lane >> 5); v[i] = __builtin_nontemporal_load(W + (size_t)(k0 + kk) * N + n0 + (lane & 31)); }
#pragma unroll
    for (int i = 0; i < 32; ++i) { const int kk = 2 * i + (lane >> 5); float x = v[i]; if (gk) x *= gk[k0 + kk]; scr[kk * 33 + (lane & 31)] = x; }
    LDS_WAIT();
    const int c = lane & 7;
#pragma unroll
    for (int j = 0; j < 4; ++j) { const int n = (lane >> 3) + 8 * j; const LAS float* s = scr + (8 * c) * 33 + n;
        u32x4 o; o.x = pkbf(s[0 * 33], s[1 * 33]); o.y = pkbf(s[2 * 33], s[3 * 33]); o.z = pkbf(s[4 * 33], s[5 * 33]); o.w = pkbf(s[6 * 33], s[7 * 33]);
        *(u32x4*)(WT + (size_t)(drow0 + n) * K + k0 + 8 * c) = o; }
    LDS_WAIT();
}
__device__ __forceinline__ int win_row(int n0) {
    if (n0 < 256) return n0;
    if (n0 < 416) return 256 + (n0 - 256);
    if (n0 < 1440) { const int isk = n0 >= 928; const int j = n0 - (isk ? 928 : 416); const int head = j >> 6, d = j & 63;
        return (isk ? 1024 : 512) + 256 * (head >> 2) + 128 * (d >> 5) + 32 * (head & 3) + (d & 31); }
    if (n0 < 2464) return 1536 + (n0 - 1440);
    if (n0 < 3488) return 2560 + (n0 - 2464);
    { const int j = n0 - 3488, br = j >> 10, ch = j & 1023; return 3584 + 256 * (ch >> 7) + 128 * br + (ch & 127); }
}
__device__ __forceinline__ int wgu_row(int n0) { const int up = n0 >= 2816; const int j = n0 - (up ? 2816 : 0); return 256 * (j >> 7) + 128 * up + (j & 127); }
__device__ __forceinline__ float wave_sum(float v) {
    v += shx<1>(v); v += shx<2>(v); v += shx<4>(v); v += shx<8>(v); v += shx<16>(v);
    return add_x32(v);
}
__device__ __forceinline__ void p0_late_weights(const Params& P, LAS unsigned char* lds, int tid, int gw, int NGW) {
    const int lane = tid & 63, wave = tid >> 6;
    unsigned char* ws = P.ws;
    LAS float* scr = (LAS float*)(lds + wave * 16384);
    constexpr int I3 = 8 * 32, I4 = 16 * 32, I5 = 16 * 32, I6 = 16 * 176, I7 = 44 * 32;
    constexpr int NITEMS = I3 + I4 + I5 + I6 + I7;
    for (int it = gw; it < NITEMS; it += NGW) {
        int r = it;
        if (r < I3) { const int kb = r / 32, nb = r % 32; cvt_item(P.w_mla_out, 1024, (bf16*)(ws + WS_WMLA), 512, 64 * kb, 32 * nb, 32 * nb, nullptr, scr, lane); continue; } r -= I3;
        if (r < I4) { const int kb = r / 32, nb = r % 32; cvt_item(P.w_ret_out, 1024, (bf16*)(ws + WS_WRET), 1024, 64 * kb, 32 * nb, 32 * nb, nullptr, scr, lane); continue; } r -= I4;
        if (r < I5) { const int kb = r / 32, nb = r % 32; cvt_item(P.w_out, 1024, (bf16*)(ws + WS_WOUT), 1024, 64 * kb, 32 * nb, 32 * nb, nullptr, scr, lane); continue; } r -= I5;
        if (r < I6) { const int kb = r / 176, nb = r % 176; cvt_item(P.w_gate_up, 5632, (bf16*)(ws + WS_WGU), 1024, 64 * kb, 32 * nb, wgu_row(32 * nb), P.g_ffn, scr, lane); continue; } r -= I6;
        { const int kb = r / 32, nb = r % 32; cvt_item(P.w_down, 1024, (bf16*)(ws + WS_WDN), 2816, 64 * kb, 32 * nb, 32 * nb, nullptr, scr, lane); }
    }
}
__device__ __forceinline__ void p0_prologue(const Params& P, LAS unsigned char* lds, int tid, bool late_in_p0) {
    const int lane = tid & 63, wave = tid >> 6;
    unsigned char* ws = P.ws;
    LAS float* scr = (LAS float*)(lds + wave * 16384);
    const int gw = blockIdx.x * NWAVES + wave, NGW = gridDim.x * NWAVES;
    constexpr int I0 = 16 * 173, I1 = 4 * 24, I2 = 2 * 32;
    constexpr int NITEMS = I0 + I1 + I2;
    for (int it = gw; it < NITEMS; it += NGW) {
        int r = it;
        if (r < I0) { const int kb = r / 173, nb = r % 173; cvt_item(P.w_in, 5536, (bf16*)(ws + WS_WIN), 1024, 64 * kb, 32 * nb, win_row(32 * nb), nullptr, scr, lane); continue; } r -= I0;
        if (r < I1) { const int kb = r / 24, nb = r % 24; cvt_item(P.w_q_b, 768, (bf16*)(ws + WS_WQB), 256, 64 * kb, 32 * nb, 32 * nb, P.g_q_a, scr, lane); continue; } r -= I1;
        { const int kb = r / 32, nb = r % 32; cvt_item(P.w_kv_b, 1024, (bf16*)(ws + WS_WKVB), 128, 64 * kb, 32 * nb, 32 * nb, P.g_kv_a, scr, lane); }
    }
    if (late_in_p0) p0_late_weights(P, lds, tid, gw, NGW);
    const int gt = blockIdx.x * NTHR + tid, NGT = gridDim.x * NTHR;
    for (int i = gt; i < 12288; i += NGT) *((u32x4*)(ws + WS_WIN + (size_t)416 * 2048) + i) = (u32x4){0u, 0u, 0u, 0u};
    for (int i0 = gt; i0 < MTOK * 48; i0 += 8 * NGT) {
        int pv[8];
#pragma unroll
        for (int k = 0; k < 8; ++k) { const int i = i0 + k * NGT; const int tok = (i < MTOK * 32) ? (i >> 5) : ((i - MTOK * 32) >> 4); pv[k] = (i < MTOK * 48) ? P.pos[tok] : 0; }
#pragma unroll
        for (int k = 0; k < 8; ++k) {
            const int i = i0 + k * NGT;
            if (i < MTOK * 48) {
                int f; float inv; float *cd, *sd;
                if (i < MTOK * 32) { f = i & 31; inv = exp2f(-(float)f * (13.287712379549449f / 32.0f)); cd = (float*)(ws + WS_COSR) + i; sd = (float*)(ws + WS_SINR) + i; }
                else { const int k2 = i - MTOK * 32; f = k2 & 15; inv = exp2f(-(float)f * (13.287712379549449f / 16.0f)); cd = (float*)(ws + WS_COSA) + k2; sd = (float*)(ws + WS_SINA) + k2; }
                const float ang = (float)pv[k] * inv;
                double rev = (double)ang * 0.15915494309189535; rev -= rint(rev);
                const float fr = (float)rev;
                *cd = __builtin_amdgcn_cosf(fr); *sd = __builtin_amdgcn_sinf(fr);
            }
        }
    }
    bf16* XN = (bf16*)(ws + WS_XN);
    f32x4 gm[4];
#pragma unroll
    for (int j = 0; j < 4; ++j) gm[j] = *((const f32x4*)P.g_mix + lane + 64 * j);
    for (int m0 = 4 * gw; m0 < MTOK; m0 += 4 * NGW) {
        f32x4 v[4][4];
#pragma unroll
        for (int q = 0; q < 4; ++q)
#pragma unroll
            for (int j = 0; j < 4; ++j) v[q][j] = __builtin_nontemporal_load((const f32x4*)(P.x + (size_t)(m0 + q) * DM) + lane + 64 * j);
#pragma unroll
        for (int q = 0; q < 4; ++q) {
            float s = 0.f;
#pragma unroll
            for (int j = 0; j < 4; ++j) s += (v[q][j][0] * v[q][j][0] + v[q][j][1] * v[q][j][1]) + (v[q][j][2] * v[q][j][2] + v[q][j][3] * v[q][j][3]);
            const float rstd = rsqrtf(wave_sum(s) * (1.f / DM) + EPSF);
            u32x2* o8 = (u32x2*)(XN + (size_t)(m0 + q) * DM) + lane;
#pragma unroll
            for (int j = 0; j < 4; ++j) { u32x2 w; w.x = pkbf(v[q][j][0] * rstd * gm[j][0], v[q][j][1] * rstd * gm[j][1]); w.y = pkbf(v[q][j][2] * rstd * gm[j][2], v[q][j][3] * rstd * gm[j][3]); o8[64 * j] = w; }
        }
    }
}

__device__ __forceinline__ void unpack8(const u32x4 w, float (&f)[8]) {
#pragma unroll
    for (int i = 0; i < 4; ++i) { f[2 * i] = bf_lo(w[i]); f[2 * i + 1] = bf_hi(w[i]); }
}
__device__ __forceinline__ u32x4 pack8(const float (&f)[8]) { u32x4 o; o.x = pkbf(f[0], f[1]); o.y = pkbf(f[2], f[3]); o.z = pkbf(f[4], f[5]); o.w = pkbf(f[6], f[7]); return o; }
__device__ __forceinline__ float ssq8(const u32x4 w) { float s = 0.f;
#pragma unroll
    for (int i = 0; i < 4; ++i) { const float a = bf_lo(w[i]), b = bf_hi(w[i]); s += a * a + b * b; }
    return s; }
__device__ __forceinline__ void norm_rope_head(const u32x4* pa, float sa, const u32x4* pb, float sb, float s1, float s2, const float* __restrict__ gain, const float* cs, const float* sn, float oscale, u32x4* dst) {
    const float rn = rsqrtf((sa * sa * s1 + sb * sb * s2) * (1.f / 96.f) + EPSF) * oscale;
    const float fa = sa * rn, fb = sb * rn;
#pragma unroll 4
    for (int c = 0; c < 8; ++c) {
        float f[8]; unpack8(pa[c], f);
        const f32x4 g0 = *(const f32x4*)(gain + 8 * c), g1 = *(const f32x4*)(gain + 8 * c + 4);
#pragma unroll
        for (int i = 0; i < 4; ++i) { f[i] *= fa * g0[i]; f[4 + i] *= fa * g1[i]; }
        dst[c] = pack8(f);
    }
#pragma unroll
    for (int c = 0; c < 2; ++c) {
        float x1[8], x2[8]; unpack8(pb[c], x1); unpack8(pb[2 + c], x2);
        const f32x4 ga0 = *(const f32x4*)(gain + 64 + 8 * c), ga1 = *(const f32x4*)(gain + 68 + 8 * c), gb0 = *(const f32x4*)(gain + 80 + 8 * c), gb1 = *(const f32x4*)(gain + 84 + 8 * c);
        const f32x4 c0 = *(const f32x4*)(cs + 8 * c), c1 = *(const f32x4*)(cs + 8 * c + 4), n0 = *(const f32x4*)(sn + 8 * c), n1 = *(const f32x4*)(sn + 8 * c + 4);
        float o1[8], o2[8];
#pragma unroll
        for (int i = 0; i < 4; ++i) {
            const float a = x1[i] * fb * ga0[i], bq = x2[i] * fb * gb0[i]; o1[i] = a * c0[i] - bq * n0[i]; o2[i] = bq * c0[i] + a * n0[i];
            const float a2 = x1[4 + i] * fb * ga1[i], b2 = x2[4 + i] * fb * gb1[i]; o1[4 + i] = a2 * c1[i] - b2 * n1[i]; o2[4 + i] = b2 * c1[i] + a2 * n1[i];
        }
        dst[8 + c] = pack8(o1); dst[10 + c] = pack8(o2);
    }
}
__device__ __forceinline__ void norm_rope_head_r(const u32x4 (&w)[12], float sa, float sb, float s1, float s2, const float* __restrict__ gain, const float* cs, const float* sn, float oscale, u32x4* dst) {
    const float rn = rsqrtf((sa * sa * s1 + sb * sb * s2) * (1.f / 96.f) + EPSF) * oscale;
    const float fa = sa * rn, fb = sb * rn;
#pragma unroll
    for (int c = 0; c < 8; ++c) {
        float f[8]; unpack8(w[c], f);
        const f32x4 g0 = *(const f32x4*)(gain + 8 * c), g1 = *(const f32x4*)(gain + 8 * c + 4);
#pragma unroll
        for (int i = 0; i < 4; ++i) { f[i] *= fa * g0[i]; f[4 + i] *= fa * g1[i]; }
        dst[c] = pack8(f);
    }
#pragma unroll
    for (int c = 0; c < 2; ++c) {
        float x1[8], x2[8]; unpack8(w[8 + c], x1); unpack8(w[10 + c], x2);
        const f32x4 ga0 = *(const f32x4*)(gain + 64 + 8 * c), ga1 = *(const f32x4*)(gain + 68 + 8 * c), gb0 = *(const f32x4*)(gain + 80 + 8 * c), gb1 = *(const f32x4*)(gain + 84 + 8 * c);
        const f32x4 c0 = *(const f32x4*)(cs + 8 * c), c1 = *(const f32x4*)(cs + 8 * c + 4), n0 = *(const f32x4*)(sn + 8 * c), n1 = *(const f32x4*)(sn + 8 * c + 4);
        float o1[8], o2[8];
#pragma unroll
        for (int i = 0; i < 4; ++i) {
            const float a = x1[i] * fb * ga0[i], bq = x2[i] * fb * gb0[i]; o1[i] = a * c0[i] - bq * n0[i]; o2[i] = bq * c0[i] + a * n0[i];
            const float a2 = x1[4 + i] * fb * ga1[i], b2 = x2[4 + i] * fb * gb1[i]; o1[4 + i] = a2 * c1[i] - b2 * n1[i]; o2[4 + i] = b2 * c1[i] + a2 * n1[i];
        }
        dst[8 + c] = pack8(o1); dst[10 + c] = pack8(o2);
    }
}
__device__ __forceinline__ void mla_prep(const Params& P, int tid) {
    unsigned char* ws = P.ws;
    const bf16* CQ = (const bf16*)(ws + WS_CQ); const bf16* CKV = (const bf16*)(ws + WS_CKV); const bf16* KROPE = (const bf16*)(ws + WS_KROPE);
    const bf16* UQ = (const bf16*)(ws + WS_UQ); const bf16* UKV = (const bf16*)(ws + WS_UKV);
    bf16* AQ = (bf16*)(ws + WS_AQ); bf16* AK = (bf16*)(ws + WS_AK); bf16* AV = (bf16*)(ws + WS_AV);
    const float* cosA = (const float*)(ws + WS_COSA); const float* sinA = (const float*)(ws + WS_SINA);
    for (int tile = blockIdx.x; tile < MTOK / 64; tile += gridDim.x) {
        const int tk = tid >> 3, hd = tid & 7, row = tile * 64 + tk, b = row >> 13, s = row & (SEQL - 1);
        const u32x4* pq = (const u32x4*)(UQ + (size_t)row * 768 + 96 * hd);
        const u32x4* pk = (const u32x4*)(UKV + (size_t)row * 1024 + 128 * hd);
        const u32x4* pr = (const u32x4*)(KROPE + (size_t)row * 32);
        const size_t orow = (size_t)(b * 8 + hd) * SEQL + s;
        const float* cs = cosA + (size_t)row * 16; const float* sn = sinA + (size_t)row * 16;
        float sq = 0.f, skv = 0.f, sq1 = 0.f, sq2 = 0.f, sk1 = 0.f, sk2 = 0.f;
        float rq, rkv;
        {
            u32x4 wq[4], wkv[2], wu[12];
            { const u32x4* p = (const u32x4*)(CQ + (size_t)row * 256 + 32 * hd);
#pragma unroll
              for (int c = 0; c < 4; ++c) wq[c] = p[c]; }
            { const u32x4* p = (const u32x4*)(CKV + (size_t)row * 128 + 16 * hd);
#pragma unroll
              for (int c = 0; c < 2; ++c) wkv[c] = p[c]; }
#pragma unroll
            for (int c = 0; c < 12; ++c) wu[c] = pq[c];
#pragma unroll
            for (int c = 0; c < 4; ++c) sq += ssq8(wq[c]);
#pragma unroll
            for (int c = 0; c < 2; ++c) skv += ssq8(wkv[c]);
#pragma unroll
            for (int c = 0; c < 8; ++c) sq1 += ssq8(wu[c]);
#pragma unroll
            for (int c = 8; c < 12; ++c) sq2 += ssq8(wu[c]);
            sq += shx<1>(sq); sq += shx<2>(sq); sq += shx<4>(sq);
            skv += shx<1>(skv); skv += shx<2>(skv); skv += shx<4>(skv);
            rq = rsqrtf(sq * (1.f / 256.f) + EPSF); rkv = rsqrtf(skv * (1.f / 128.f) + EPSF);
            norm_rope_head_r(wu, rq, rq, sq1, sq2, P.g_qn, cs, sn, QSCALE, (u32x4*)(AQ + orow * 96));
        }
        asm volatile("" ::: "memory");
        {
            u32x4 wk[12], wv[8];
#pragma unroll
            for (int c = 0; c < 8; ++c) { wk[c] = pk[c]; wv[c] = pk[8 + c]; }
#pragma unroll
            for (int c = 0; c < 4; ++c) wk[8 + c] = pr[c];
#pragma unroll
            for (int c = 0; c < 8; ++c) sk1 += ssq8(wk[c]);
#pragma unroll
            for (int c = 8; c < 12; ++c) sk2 += ssq8(wk[c]);
            norm_rope_head_r(wk, rkv, 1.f, sk1, sk2, P.g_kn, cs, sn, 1.f, (u32x4*)(AK + orow * 96));
            u32x4* qv = (u32x4*)(AV + orow * 64);
#pragma unroll
            for (int c = 0; c < 8; ++c) { float f[8]; unpack8(wv[c], f);
#pragma unroll
                for (int i = 0; i < 8; ++i) f[i] *= rkv;
                qv[c] = pack8(f); }
        }
    }
}

constexpr int KPITCH = 208, VPITCH = 144, KBUF = 64 * KPITCH, VBUF = 64 * VPITCH;
constexpr int AT_K0 = 0, AT_V0 = 3 * KBUF;
constexpr float ATT_THR = 16.0f;
__device__ __forceinline__ float max3f(float a, float b, float c) { float r; asm("v_max3_f32 %0, %1, %2, %3" : "=v"(r) : "v"(a), "v"(b), "v"(c)); return r; }
template <bool LATE, bool NOMAX>
__device__ __forceinline__ void attn_unit(LAS unsigned char* lds, const bf16* AQ, const bf16* AK, const bf16* AV, bf16* AO, int bh, int qb, int tid) {
    const int lane = tid & 63, wid = tid >> 6, r32 = lane & 31, hi = lane >> 5;
    constexpr int NT = SEQL / 64;
    const size_t rowQ = (size_t)bh * SEQL + qb * 256 + wid * 32 + r32;
    bf16x8 qf[6];
#pragma unroll
    for (int s = 0; s < 6; ++s) qf[s] = *(const bf16x8*)(AQ + rowQ * 96 + 16 * s + 8 * hi);
    const unsigned char* Kg = (const unsigned char*)(AK + (size_t)bh * SEQL * 96);
    const unsigned char* Vg = (const unsigned char*)(AV + (size_t)bh * SEQL * 64);
    const int t2 = tid & 255;
    unsigned koff[3];
#pragma unroll
    for (int j = 0; j < 3; ++j) { const int c = t2 + 256 * j; koff[j] = (c / 12) * KPITCH + (c % 12) * 16; }
    const int vkey = t2 & 63, vdch = t2 >> 6, k15 = vkey & 15;
    const int vpos = 16 * (vkey >> 4) + (k15 & 3) + 4 * ((k15 >> 3) & 1) + 8 * ((k15 >> 2) & 1);
    const unsigned voff = (8 * vdch) * VPITCH + vpos * 2, vgoff = vkey * 128 + vdch * 16;
    f32x16 o0, o1, S0, S1, zero16;
#pragma unroll
    for (int r = 0; r < 16; ++r) { o0[r] = 0.f; o1[r] = 0.f; zero16[r] = 0.f; }
    float m = 0.f, lsum = 0.f;
    u32x4 kr[3], vr[2];
    const int rot = 4 * qb;
#define AT_TT(t) (((t) + rot) & (NT - 1))
#define AT_LOADK(t) do { if (!LATE) { const unsigned char* kg_ = Kg + (size_t)AT_TT(t) * 12288 + t2 * 16; _Pragma("unroll") for (int j = 0; j < 3; ++j) kr[j] = *(const u32x4*)(kg_ + 4096 * j); } } while (0)
#define AT_LOADV(t) do { if (!LATE) { const unsigned char* vg_ = Vg + (size_t)AT_TT(t) * 8192 + vgoff; vr[0] = *(const u32x4*)vg_; vr[1] = *(const u32x4*)(vg_ + 64); } } while (0)
#define AT_WRITEK(slot) do { if (!LATE) { _Pragma("unroll") for (int j = 0; j < 3; ++j) *(LAS u32x4*)(lds + AT_K0 + (slot) * KBUF + koff[j]) = kr[j]; } } while (0)
#define AT_WRITEV(slot) do { if (!LATE) { _Pragma("unroll") for (int jv = 0; jv < 2; ++jv) { LAS unsigned char* vb_ = lds + AT_V0 + (slot) * VBUF + voff + jv * 32 * VPITCH; \
        _Pragma("unroll") for (int e = 0; e < 8; ++e) *(LAS unsigned short*)(vb_ + e * VPITCH) = (unsigned short)((e & 1) ? (vr[jv][e >> 1] >> 16) : (vr[jv][e >> 1] & 0xffffu)); } } } while (0)
#define AT_KLOAD(slot) do { const LAS unsigned char* kb_ = lds + AT_K0 + (slot) * KBUF + r32 * KPITCH + 16 * hi; \
        _Pragma("unroll") for (int s = 0; s < 6; ++s) { kf0[s] = *(const LAS bf16x8*)(kb_ + 32 * s); kf1[s] = *(const LAS bf16x8*)(kb_ + 32 * KPITCH + 32 * s); } } while (0)
#define AT_VLOAD(slot) do { const LAS unsigned char* vb_ = lds + AT_V0 + (slot) * VBUF + r32 * VPITCH + 16 * hi; \
        _Pragma("unroll") for (int ks = 0; ks < 4; ++ks) { vf0[ks] = *(const LAS bf16x8*)(vb_ + 32 * ks); vf1[ks] = *(const LAS bf16x8*)(vb_ + 32 * VPITCH + 32 * ks); } } while (0)
#define AT_QK() do { __builtin_amdgcn_s_setprio(1); \
        _Pragma("unroll") for (int s = 0; s < 6; ++s) { \
            if (s == 0) { S0 = MFMA32(kf0[0], qf[0], zero16); S1 = MFMA32(kf1[0], qf[0], zero16); } else { S0 = MFMA32(kf0[s], qf[s], S0); S1 = MFMA32(kf1[s], qf[s], S1); } } __builtin_amdgcn_s_setprio(0); } while (0)
    bf16x8 kf0[6], kf1[6], vf0[4], vf1[4];
    AT_LOADK(0); AT_LOADV(0); AT_WRITEK(0); AT_WRITEV(0); AT_LOADK(1); AT_WRITEK(1);
    __syncthreads();
    AT_KLOAD(0);
    if (LATE) AT_QK();
    int ks_cur = 0, ks_nxt = 1, ks_wr = 2;
    for (int kt = 0; kt < NT; ++kt) {
        const int vcur = kt & 1;
        if (kt + 2 < NT) AT_LOADK(kt + 2);
        if (kt + 1 < NT) AT_LOADV(kt + 1);
        if (LATE) { AT_VLOAD(vcur); if (kt + 1 < NT) AT_KLOAD(ks_nxt); }
        __builtin_amdgcn_sched_barrier(0);
        if (!LATE) { AT_QK(); AT_VLOAD(vcur); __builtin_amdgcn_sched_barrier(0); }
        if (!NOMAX) {
            if (__any(m != 0.f)) {
    #pragma unroll
                for (int r = 0; r < 16; ++r) { S0[r] -= m; S1[r] -= m; }
            }
            asm volatile("s_nop 15\n\ts_nop 15" : "+v"(S0), "+v"(S1));
            float mx;
            { float a_ = max3f(S0[0], S0[1], S1[0]), b_ = max3f(S0[2], S0[3], S1[1]); a_ = max3f(a_, S1[2], S1[3]);
    #pragma unroll
              for (int r = 4; r < 16; r += 4) { a_ = max3f(a_, S0[r], S0[r + 1]); b_ = max3f(b_, S0[r + 2], S0[r + 3]); a_ = max3f(a_, S1[r], S1[r + 1]); b_ = max3f(b_, S1[r + 2], S1[r + 3]); }
              mx = max3f(a_, b_, b_); }
            mx = max_x32(mx);
            if (__any(mx > ATT_THR) || (kt == 0 && __any(mx < -ATT_THR))) {
                const float dl = (mx > ATT_THR || kt == 0) ? mx : 0.f;
                const float al = ex2(-dl); m += dl;
    #pragma unroll
                for (int r = 0; r < 16; ++r) { o0[r] *= al; o1[r] *= al; S0[r] -= dl; S1[r] -= dl; }
                lsum *= al;
            }
        }
#pragma unroll
        for (int r = 0; r < 16; ++r) { S0[r] = ex2(S0[r]); S1[r] = ex2(S1[r]); }
#pragma unroll
        for (int r = 0; r < 16; ++r) { lsum += S0[r]; lsum += S1[r]; }
#pragma unroll
        for (int ks = 0; ks < 4; ++ks) {
            u32x4 pw;
            if (ks < 2) { pw.x = pkbf(S0[8 * ks], S0[8 * ks + 1]); pw.y = pkbf(S0[8 * ks + 2], S0[8 * ks + 3]); pw.z = pkbf(S0[8 * ks + 4], S0[8 * ks + 5]); pw.w = pkbf(S0[8 * ks + 6], S0[8 * ks + 7]); }
            else { const int k2 = ks - 2; pw.x = pkbf(S1[8 * k2], S1[8 * k2 + 1]); pw.y = pkbf(S1[8 * k2 + 2], S1[8 * k2 + 3]); pw.z = pkbf(S1[8 * k2 + 4], S1[8 * k2 + 5]); pw.w = pkbf(S1[8 * k2 + 6], S1[8 * k2 + 7]); }
            const bf16x8 pf = __builtin_bit_cast(bf16x8, pw);
            o0 = MFMA32(vf0[ks], pf, o0); o1 = MFMA32(vf1[ks], pf, o1);
        }
        if (LATE) { if (kt + 1 < NT) AT_QK(); }
        else { if (kt + 1 < NT) { AT_KLOAD(ks_nxt); __builtin_amdgcn_sched_barrier(0); } }
        if (kt + 2 < NT) AT_WRITEK(ks_wr);
        if (kt + 1 < NT) AT_WRITEV(vcur ^ 1);
        __syncthreads();
        { const int t_ = ks_cur; ks_cur = ks_nxt; ks_nxt = ks_wr; ks_wr = t_; }
    }
#undef AT_LOADK
#undef AT_TT
#undef AT_LOADV
#undef AT_WRITEK
#undef AT_WRITEV
#undef AT_QK
#undef AT_KLOAD
#undef AT_VLOAD
    const float il = 1.f / add_x32(lsum);
    const int b = bh >> 3, h = bh & 7;
    bf16* orow = AO + ((size_t)b * SEQL + qb * 256 + wid * 32 + r32) * 512 + h * 64 + 4 * hi;
#pragma unroll
    for (int g = 0; g < 4; ++g) {
        u32x2 w0, w1;
        w0.x = pkbf(o0[4 * g] * il, o0[4 * g + 1] * il); w0.y = pkbf(o0[4 * g + 2] * il, o0[4 * g + 3] * il);
        w1.x = pkbf(o1[4 * g] * il, o1[4 * g + 1] * il); w1.y = pkbf(o1[4 * g + 2] * il, o1[4 * g + 3] * il);
        *(u32x2*)(orow + 8 * g) = w0; *(u32x2*)(orow + 32 + 8 * g) = w1;
    }
}

__device__ __forceinline__ float lg2_of(const float* dec, int h) { return -expf(dec[h]) * LOG2E; }
__device__ __forceinline__ void ret_scan(const Params& P, int tid) {
    bf16* LT = (bf16*)(P.ws + WS_LT);
    const int gt = blockIdx.x * NTHR + tid, NGT = gridDim.x * NTHR;
    for (int e = gt; e < 2 * 16 * 8192; e += NGT) {
        const int dir = e >> 17, bh = (e >> 13) & 15, el = e & 8191, h = bh & 7;
        const float g = ex2(lg2_of(dir ? P.dec_b : P.dec_f, h) * 128.f);
        bf16* base = LT + (size_t)((dir * 16 + bh) * 64) * 8192 + el;
        float st = 0.f;
        for (int c8 = 0; c8 < 8; ++c8) {
            float L[8];
#pragma unroll
            for (int i = 0; i < 8; ++i) { const int c = dir ? 63 - (8 * c8 + i) : 8 * c8 + i; L[i] = __uint_as_float((unsigned)base[(size_t)c * 8192] << 16); }
#pragma unroll
            for (int i = 0; i < 8; ++i) { const int c = dir ? 63 - (8 * c8 + i) : 8 * c8 + i; base[(size_t)c * 8192] = (bf16)(pkbf(st, 0.f) & 0xffffu); st = st * g + L[i]; }
        }
    }
}
__device__ __forceinline__ void ret_local_lds(const Params& P, LAS unsigned char* lds, int tid) {
    constexpr int LK = 0, LKP = 144, LV = 128 * 144, LVP = 272;
    unsigned char* ws = P.ws;
    const bf16* RK = (const bf16*)(ws + WS_RK); const bf16* VR = (const bf16*)(ws + WS_VR); bf16* LT = (bf16*)(ws + WS_LT);
    const int lane = tid & 63, wid = tid >> 6, r32 = lane & 31, hi = lane >> 5, dvb = wid & 3, dkb = wid >> 2;
    const int kt0 = tid >> 3, kp0 = tid & 7;
    const int vtok = tid & 127, vp0 = tid >> 7, t15 = vtok & 15;
    const int vpos = 16 * (vtok >> 4) + (t15 & 3) + 4 * ((t15 >> 3) & 1) + 8 * ((t15 >> 2) & 1);
    u32x4 gk[2], gv[4];
#define RL_LOAD(item_) do { const int bh_ = (item_) >> 6, ch_ = (item_) & 63, b_ = bh_ >> 3, h_ = bh_ & 7; const size_t t0_ = (size_t)b_ * SEQL + ch_ * 128; \
        _Pragma("unroll") for (int j = 0; j < 2; ++j) gk[j] = *(const u32x4*)(RK + (t0_ + kt0 + 64 * j) * 512 + h_ * 64 + kp0 * 8); \
        _Pragma("unroll") for (int j = 0; j < 4; ++j) gv[j] = *(const u32x4*)(VR + (t0_ + vtok) * 1024 + h_ * 128 + (vp0 + 4 * j) * 8); } while (0)
#define RL_STORE() do { \
        _Pragma("unroll") for (int j = 0; j < 2; ++j) *(LAS u32x4*)(lds + LK + (kt0 + 64 * j) * LKP + kp0 * 16) = gk[j]; \
        _Pragma("unroll") for (int j = 0; j < 4; ++j) { LAS unsigned char* vb_ = lds + LV + (8 * (vp0 + 4 * j)) * LVP + vpos * 2; \
            _Pragma("unroll") for (int e = 0; e < 8; ++e) *(LAS unsigned short*)(vb_ + e * LVP) = (unsigned short)((e & 1) ? (gv[j][e >> 1] >> 16) : (gv[j][e >> 1] & 0xffffu)); } } while (0)
    int item = blockIdx.x;
    if (item < 1024) RL_LOAD(item);
    for (; item < 1024; item += gridDim.x) {
        const int bh = item >> 6, ch = item & 63, h = bh & 7;
        RL_STORE();
        __syncthreads();
        if (item + (int)gridDim.x < 1024) RL_LOAD(item + (int)gridDim.x);
        const float lgf = lg2_of(P.dec_f, h), lgb = lg2_of(P.dec_b, h);
        f32x16 accf, accb;
#pragma unroll
        for (int r = 0; r < 16; ++r) { accf[r] = 0.f; accb[r] = 0.f; }
        const LAS unsigned char* vb = lds + LV + (32 * dvb + r32) * LVP + 16 * hi; const LAS unsigned char* kb = lds + LK + (32 * dkb + r32) * 2;
#pragma unroll 2
        for (int s = 0; s < 8; ++s) {
            const bf16x8 af = *(const LAS bf16x8*)(vb + 32 * s);
            float kf[8], kq[8];
#pragma unroll
            for (int jj = 0; jj < 8; ++jj) {
                const int j = 16 * s + (jj & 3) + 8 * (jj >> 2) + 4 * hi;
                const float kv = __uint_as_float((unsigned)(*(const LAS unsigned short*)(kb + j * LKP)) << 16);
                kf[jj] = kv * ex2(lgf * (float)(127 - j)); kq[jj] = kv * ex2(lgb * (float)j);
            }
            u32x4 w0, w1;
            w0.x = pkbf(kf[0], kf[1]); w0.y = pkbf(kf[2], kf[3]); w0.z = pkbf(kf[4], kf[5]); w0.w = pkbf(kf[6], kf[7]);
            w1.x = pkbf(kq[0], kq[1]); w1.y = pkbf(kq[2], kq[3]); w1.z = pkbf(kq[4], kq[5]); w1.w = pkbf(kq[6], kq[7]);
            accf = MFMA32(af, __builtin_bit_cast(bf16x8, w0), accf); accb = MFMA32(af, __builtin_bit_cast(bf16x8, w1), accb);
        }
        bf16* opf = LT + ((size_t)((0 * 16 + bh) * 64 + ch) * 128 + 32 * dvb) * 64 + 32 * dkb + r32;
        bf16* opb = LT + ((size_t)((1 * 16 + bh) * 64 + ch) * 128 + 32 * dvb) * 64 + 32 * dkb + r32;
#pragma unroll
        for (int r = 0; r < 16; ++r) { const int dv = crow(r, hi); opf[(size_t)dv * 64] = (bf16)(pkbf(accf[r], 0.f) & 0xffffu); opb[(size_t)dv * 64] = (bf16)(pkbf(accb[r], 0.f) & 0xffffu); }
        __syncthreads();
    }
#undef RL_LOAD
#undef RL_STORE
}

constexpr int RO_KP = 144, RO_VP = 272, RO_SP = 144;
constexpr int RO_K = 0, RO_V = RO_K + 128 * RO_KP, RO_SF = RO_V + 128 * RO_VP, RO_SB = RO_SF + 128 * RO_SP, RO_X = RO_SB + 128 * RO_SP, RO_END = RO_X + 8 * 32 * 4;
__device__ __forceinline__ void ret_out_lds(const Params& P, LAS unsigned char* lds, int tid) {
    unsigned char* ws = P.ws;
    const bf16* RQ = (const bf16*)(ws + WS_RQ); const bf16* RK = (const bf16*)(ws + WS_RK); const bf16* VR = (const bf16*)(ws + WS_VR); const bf16* GR = (const bf16*)(ws + WS_GR);
    const bf16* ST = (const bf16*)(ws + WS_LT); bf16* OB = (bf16*)(ws + WS_OB);
    const int lane = tid & 63, wid = tid >> 6, r32 = lane & 31, hi = lane >> 5, ib = wid & 3, dvh = wid >> 2;
    const int kt0 = tid >> 3, kp0 = tid & 7;
    const int vtok = tid & 127, vp0 = tid >> 7, t15 = vtok & 15;
    const int vpos = 16 * (vtok >> 4) + (t15 & 3) + 4 * ((t15 >> 3) & 1) + 8 * ((t15 >> 2) & 1);
    u32x4 gk[2], gv[4], gf[2], gb[2];
#define RO_LOAD(item_) do { const int bh_ = (item_) >> 6, ch_ = (item_) & 63, b_ = bh_ >> 3, h_ = bh_ & 7; const size_t t0_ = (size_t)b_ * SEQL + ch_ * 128; \
        _Pragma("unroll") for (int j = 0; j < 2; ++j) gk[j] = *(const u32x4*)(RK + (t0_ + kt0 + 64 * j) * 512 + h_ * 64 + kp0 * 8); \
        _Pragma("unroll") for (int j = 0; j < 4; ++j) gv[j] = *(const u32x4*)(VR + (t0_ + vtok) * 1024 + h_ * 128 + (vp0 + 4 * j) * 8); \
        const bf16* sf_ = ST + (size_t)((0 * 16 + bh_) * 64 + ch_) * 8192; const bf16* sb_ = ST + (size_t)((1 * 16 + bh_) * 64 + ch_) * 8192; \
        _Pragma("unroll") for (int j = 0; j < 2; ++j) { gf[j] = *(const u32x4*)(sf_ + (kt0 + 64 * j) * 64 + kp0 * 8); gb[j] = *(const u32x4*)(sb_ + (kt0 + 64 * j) * 64 + kp0 * 8); } } while (0)
#define RO_STORE() do { \
        _Pragma("unroll") for (int j = 0; j < 2; ++j) { *(LAS u32x4*)(lds + RO_K + (kt0 + 64 * j) * RO_KP + kp0 * 16) = gk[j]; \
            *(LAS u32x4*)(lds + RO_SF + (kt0 + 64 * j) * RO_SP + kp0 * 16) = gf[j]; *(LAS u32x4*)(lds + RO_SB + (kt0 + 64 * j) * RO_SP + kp0 * 16) = gb[j]; } \
        _Pragma("unroll") for (int j = 0; j < 4; ++j) { LAS unsigned char* vb_ = lds + RO_V + (8 * (vp0 + 4 * j)) * RO_VP + vpos * 2; \
            _Pragma("unroll") for (int e = 0; e < 8; ++e) *(LAS unsigned short*)(vb_ + e * RO_VP) = (unsigned short)((e & 1) ? (gv[j][e >> 1] >> 16) : (gv[j][e >> 1] & 0xffffu)); } } while (0)
    int item = blockIdx.x;
    if (item < 1024) RO_LOAD(item);
    for (; item < 1024; item += gridDim.x) {
        const int bh = item >> 6, ch = item & 63, b = bh >> 3, h = bh & 7;
        const size_t tok0 = (size_t)b * SEQL + ch * 128;
        RO_STORE();
        __syncthreads();
        if (item + (int)gridDim.x < 1024) RO_LOAD(item + (int)gridDim.x);
        const int il = 32 * ib + r32;
        const float lgf = lg2_of(P.dec_f, h), lgb = lg2_of(P.dec_b, h);
        bf16x8 qf[4];
#pragma unroll
        for (int s = 0; s < 4; ++s) qf[s] = *(const bf16x8*)(RQ + (tok0 + il) * 512 + h * 64 + 16 * s + 8 * hi);
        f32x16 acc[2];
#pragma unroll
        for (int d = 0; d < 2; ++d)
#pragma unroll
            for (int r = 0; r < 16; ++r) acc[d][r] = 0.f;
        const LAS unsigned char* sfb = lds + RO_SF + (64 * dvh + r32) * RO_SP + 16 * hi; const LAS unsigned char* sbb = lds + RO_SB + (64 * dvh + r32) * RO_SP + 16 * hi;
#pragma unroll
        for (int d = 0; d < 2; ++d)
#pragma unroll
            for (int s = 0; s < 4; ++s) { const bf16x8 a = *(const LAS bf16x8*)(sfb + 32 * d * RO_SP + 32 * s); acc[d] = MFMA32(a, qf[s], acc[d]); }
        const float wb = ex2(lgb * (float)(128 - il)), ratio = ex2(lgf * (float)(il + 1) - lgb * (float)(128 - il));
#pragma unroll
        for (int d = 0; d < 2; ++d)
#pragma unroll
            for (int r = 0; r < 16; ++r) acc[d][r] *= ratio;
#pragma unroll
        for (int d = 0; d < 2; ++d)
#pragma unroll
            for (int s = 0; s < 4; ++s) { const bf16x8 a = *(const LAS bf16x8*)(sbb + 32 * d * RO_SP + 32 * s); acc[d] = MFMA32(a, qf[s], acc[d]); }
#pragma unroll
        for (int d = 0; d < 2; ++d)
#pragma unroll
            for (int r = 0; r < 16; ++r) acc[d][r] *= wb;
        const LAS unsigned char* kb = lds + RO_K + r32 * RO_KP + 16 * hi; const LAS unsigned char* vb = lds + RO_V + (64 * dvh + r32) * RO_VP + 16 * hi;
#pragma unroll 2
        for (int jb = 0; jb < 4; ++jb) {
            f32x16 st;
#pragma unroll
            for (int r = 0; r < 16; ++r) st[r] = 0.f;
#pragma unroll
            for (int s = 0; s < 4; ++s) { const bf16x8 a = *(const LAS bf16x8*)(kb + 32 * jb * RO_KP + 32 * s); st = MFMA32(a, qf[s], st); }
#pragma unroll
            for (int r = 0; r < 16; ++r) { const int df = il - (32 * jb + crow(r, hi)); st[r] *= (df >= 0) ? ex2(lgf * (float)df) : ex2(lgb * (float)(-df)); }
#pragma unroll
            for (int ks = 0; ks < 2; ++ks) {
                u32x4 pw; pw.x = pkbf(st[8 * ks], st[8 * ks + 1]); pw.y = pkbf(st[8 * ks + 2], st[8 * ks + 3]); pw.z = pkbf(st[8 * ks + 4], st[8 * ks + 5]); pw.w = pkbf(st[8 * ks + 6], st[8 * ks + 7]);
                const bf16x8 pf = __builtin_bit_cast(bf16x8, pw);
#pragma unroll
                for (int d = 0; d < 2; ++d) { const bf16x8 af = *(const LAS bf16x8*)(vb + 32 * d * RO_VP + (32 * jb + 16 * ks) * 2); acc[d] = MFMA32(af, pf, acc[d]); }
            }
        }
        float ss = 0.f;
#pragma unroll
        for (int d = 0; d < 2; ++d)
#pragma unroll
            for (int r = 0; r < 16; ++r) ss += acc[d][r] * acc[d][r];
        ss = add_x32(ss);
        LAS float* X = (LAS float*)(lds + RO_X);
        if (hi == 0) X[wid * 32 + r32] = ss;
        __syncthreads();
        ss += X[(wid ^ 4) * 32 + r32];
        const float rstd = rsqrtf(ss * (1.f / 128.f) + EPSF);
        const size_t obase = (tok0 + il) * 1024 + h * 128 + 64 * dvh + 4 * hi;
#pragma unroll
        for (int d = 0; d < 2; ++d)
#pragma unroll
            for (int g = 0; g < 4; ++g) {
                const u32x2 gw2 = *(const u32x2*)(GR + obase + 32 * d + 8 * g);
                const float g0 = bf_lo(gw2.x), g1 = bf_hi(gw2.x), g2 = bf_lo(gw2.y), g3 = bf_hi(gw2.y);
                u32x2 o;
                o.x = pkbf(g0 * pg8::sigm(g0) * acc[d][4 * g] * rstd, g1 * pg8::sigm(g1) * acc[d][4 * g + 1] * rstd);
                o.y = pkbf(g2 * pg8::sigm(g2) * acc[d][4 * g + 2] * rstd, g3 * pg8::sigm(g3) * acc[d][4 * g + 3] * rstd);
                *(u32x2*)(OB + obase + 32 * d + 8 * g) = o;
            }
        __syncthreads();
    }
#undef RO_LOAD
#undef RO_STORE
}

#define XB_TMO      128
#define XB_XCNT(j)  (256  + 64 * (j))
#define XB_XSUB(j)  (1280 + 64 * (j))
#define XB_XGEN(j)  (2304 + 64 * (j))
#define XB_TOP      3328
#define XB_TOPGEN   3392
#define XCD_BAR_WORDS 3456
#define XB_SPIN_CAP (1u << 18)

__device__ __forceinline__ unsigned xb_ld(unsigned* p)              { return __hip_atomic_load(p, __ATOMIC_RELAXED, __HIP_MEMORY_SCOPE_AGENT); }
__device__ __forceinline__ unsigned xb_add(unsigned* p, unsigned v) { return __hip_atomic_fetch_add(p, v, __ATOMIC_RELAXED, __HIP_MEMORY_SCOPE_AGENT); }
__device__ __forceinline__ unsigned xb_xcc_id() { return (unsigned)__builtin_amdgcn_s_getreg((3 << 11) | 20) & 0xFu; }
#define XB_SPIN(cond, bar) do { unsigned _sp = 0; while (cond) { __builtin_amdgcn_s_sleep(1); \
    if ((++_sp & 255u) == 0u) { if (xb_ld(&(bar)[XB_TMO])) break; if (_sp > XB_SPIN_CAP) { atomicAdd(&(bar)[XB_TMO], 1u); break; } } } } while (0)

struct XcdBarrier {
    unsigned* bar; unsigned x;
    volatile LAS unsigned* st;
};

__device__ __forceinline__ XcdBarrier xcd_barrier_post(unsigned* bar, volatile LAS unsigned* st) {
    XcdBarrier b; b.bar = bar; b.x = xb_xcc_id(); b.st = st;
    if (threadIdx.x == 0) (void)xb_add(&bar[XB_XCNT(b.x)], 1u);
    return b;
}
__device__ __forceinline__ void xcd_barrier_complete(unsigned* bar, unsigned x, unsigned& nloc, unsigned& nx) {
    const unsigned G = gridDim.x * gridDim.y * gridDim.z;
    unsigned sum, cnt, mine, sp = 0u;
    for (;;) {
        sum = 0u; cnt = 0u; mine = 0u;
#pragma unroll
        for (unsigned j = 0; j < 16; ++j) { const unsigned c = xb_ld(&bar[XB_XCNT(j)]); sum += c; cnt += (c > 0u) ? 1u : 0u; mine = (j == x) ? c : mine; }
        if (sum == G) break;
        __builtin_amdgcn_s_sleep(1);
        if ((++sp & 255u) == 0u) { if (xb_ld(&bar[XB_TMO])) break; if (sp > XB_SPIN_CAP) { atomicAdd(&bar[XB_TMO], 1u); break; } }
    }
    nloc = mine > 0u ? mine : 1u; nx = cnt > 0u ? cnt : 1u;
}

__device__ __forceinline__ void xcd_barrier(const XcdBarrier& b) {
    asm volatile("s_waitcnt vmcnt(0)" ::: "memory");
    __syncthreads();
    if (threadIdx.x == 0) {
        unsigned* bar = b.bar;
        __builtin_amdgcn_s_waitcnt(0);
        unsigned nloc = b.st[0], nx = b.st[1];
        if (nloc == 0u) { xcd_barrier_complete(bar, b.x, nloc, nx); b.st[0] = nloc; b.st[1] = nx; }
        const unsigned old = xb_add(&bar[XB_XSUB(b.x)], 1u);
        const unsigned gen = old / nloc;
        if (old + 1u == (gen + 1u) * nloc) {
            __builtin_amdgcn_fence(__ATOMIC_RELEASE, "agent");
            asm volatile("s_waitcnt vmcnt(0)" ::: "memory");
            const unsigned og = xb_add(&bar[XB_TOP], 1u);
            const unsigned tg = og / nx;
            if (og + 1u == (tg + 1u) * nx) xb_add(&bar[XB_TOPGEN], 1u);
            else XB_SPIN(xb_ld(&bar[XB_TOPGEN]) == tg, bar);
            __builtin_amdgcn_fence(__ATOMIC_ACQUIRE, "agent");
            xb_add(&bar[XB_XGEN(b.x)], 1u);
            asm volatile("s_waitcnt vmcnt(0)" ::: "memory");
        } else {
            XB_SPIN(xb_ld(&bar[XB_XGEN(b.x)]) == gen, bar);
            __builtin_amdgcn_fence(__ATOMIC_ACQUIRE, "agent");
            asm volatile("s_waitcnt vmcnt(0)" ::: "memory");
        }
    }
    __syncthreads();
}

__global__ void __launch_bounds__(NTHR, 2) fwd_kernel(Params P) {
    extern __shared__ __attribute__((aligned(16))) unsigned char lds_raw[];
    LAS unsigned char* lds = (LAS unsigned char*)lds_raw;
    cg::grid_group grid = cg::this_grid();
    const int G = gridDim.x, bid = blockIdx.x;
    volatile LAS unsigned* MISC = (volatile LAS unsigned*)(lds + 131072);
    unsigned* barw = (unsigned*)(P.ws + WS_BAR);
    if (threadIdx.x < 2) MISC[threadIdx.x] = 0u;
    __syncthreads();
    XcdBarrier bar = xcd_barrier_post(barw, MISC);
    if (P.ws == nullptr) grid.sync();
    const int wave_s = __builtin_amdgcn_readfirstlane((int)threadIdx.x >> 6);
#define TIDP() ({ int l_; asm volatile("v_mbcnt_lo_u32_b32 %0, -1, 0\n\tv_mbcnt_hi_u32_b32 %0, -1, %0" : "=v"(l_)); wave_s * 64 + l_; })
    unsigned char* ws = P.ws;
    bf16* XN = (bf16*)(ws + WS_XN);
    pg8::EpiProj EP; EP.t0 = 0; EP.ws = ws;

    p0_prologue(P, lds, TIDP(), G <= 128);
        xcd_barrier(bar);
    {
    { pg8::Gemm g{XN, (const bf16*)(ws + WS_WIN), MTOK, 512, 1024}; pg8::StaticOrder S; S.init(MTOK, 512, G, bid); EP.t0 = 0;
      pg8::gemm_phase<pg8::EpiProj, pg8::StaticOrder, true, true>(lds, g, S, EP, TIDP()); }
    if (G > 128 && bid >= 128) { const int t_ = TIDP(); p0_late_weights(P, lds, t_, (bid - 128) * NWAVES + (t_ >> 6), (G - 128) * NWAVES); }
    }
    xcd_barrier(bar);
    {
    { int Kq = 256; asm volatile("" : "+s"(Kq)); pg8::Gemm g{(const bf16*)(ws + WS_CQ), (const bf16*)(ws + WS_WQB), MTOK, 768, Kq}; pg8::StaticOrder S; S.init(MTOK, 768, G, bid); pg8::EpiBf16S E{(bf16*)(ws + WS_UQ), 768};
      pg8::gemm_phase<pg8::EpiBf16S, pg8::StaticOrder, true, true>(lds, g, S, E, TIDP()); }
    { int Kk = 128; asm volatile("" : "+s"(Kk)); pg8::Gemm g{(const bf16*)(ws + WS_CKV), (const bf16*)(ws + WS_WKVB), MTOK, 1024, Kk}; pg8::StaticOrder S; S.init(MTOK, 1024, G, bid); pg8::EpiBf16S E{(bf16*)(ws + WS_UKV), 1024};
      pg8::gemm_phase<pg8::EpiBf16S, pg8::StaticOrder, true, true>(lds, g, S, E, TIDP()); }
    }
    xcd_barrier(bar);
    mla_prep(P, TIDP());
    xcd_barrier(bar);
    bool nomax;
    { float gq = 0.f, gk = 0.f;
      for (int i = 0; i < 96; ++i) { gq = fmaxf(gq, fabsf(P.g_qn[i])); gk = fmaxf(gk, fabsf(P.g_kn[i])); }
      const float bound = 9.797958971f * LOG2E * gq * gk;
      nomax = __builtin_amdgcn_readfirstlane((bound < 100.f) ? 1 : 0) != 0; }
    for (int u = bid; u < 512; u += G) {
        const int bh = (u & 7) * 2 + (u >> 8), qb = (u >> 3) & 31;
        if (nomax) {
            if (wave_s < 4) attn_unit<false, true>(lds, (const bf16*)(ws + WS_AQ), (const bf16*)(ws + WS_AK), (const bf16*)(ws + WS_AV), (bf16*)(ws + WS_AO), bh, qb, TIDP());
            else attn_unit<true, true>(lds, (const bf16*)(ws + WS_AQ), (const bf16*)(ws + WS_AK), (const bf16*)(ws + WS_AV), (bf16*)(ws + WS_AO), bh, qb, TIDP());
        } else {
            if (wave_s < 4) attn_unit<false, false>(lds, (const bf16*)(ws + WS_AQ), (const bf16*)(ws + WS_AK), (const bf16*)(ws + WS_AV), (bf16*)(ws + WS_AO), bh, qb, TIDP());
            else attn_unit<true, false>(lds, (const bf16*)(ws + WS_AQ), (const bf16*)(ws + WS_AK), (const bf16*)(ws + WS_AV), (bf16*)(ws + WS_AO), bh, qb, TIDP());
        }
    }
    { pg8::Gemm g{XN, (const bf16*)(ws + WS_WIN) + (size_t)2 * 256 * 1024, MTOK, 3072, 1024}; pg8::StaticOrder S; S.init(MTOK, 3072, G, bid); EP.t0 = 2;
      pg8::gemm_phase<pg8::EpiProj, pg8::StaticOrder, true, true>(lds, g, S, EP, TIDP()); }
    xcd_barrier(bar);
    ret_local_lds(P, lds, TIDP());
    xcd_barrier(bar);
    ret_scan(P, TIDP());
    xcd_barrier(bar);
    ret_out_lds(P, lds, TIDP());
    xcd_barrier(bar);
    {
    { pg8::Gemm g{(const bf16*)(ws + WS_AO), (const bf16*)(ws + WS_WMLA), MTOK, 1024, 512}; pg8::StaticOrder S; S.init(MTOK, 1024, G, bid); pg8::EpiBf16S E{(bf16*)(ws + WS_YA), 1024};
      pg8::gemm_phase<pg8::EpiBf16S, pg8::StaticOrder, true, true>(lds, g, S, E, TIDP()); }
    { pg8::Gemm g{(const bf16*)(ws + WS_OB), (const bf16*)(ws + WS_WRET), MTOK, 1024, 1024}; pg8::StaticOrder S; S.init(MTOK, 1024, G, bid); pg8::EpiBf16S E{(bf16*)(ws + WS_YB), 1024};
      pg8::gemm_phase<pg8::EpiBf16S, pg8::StaticOrder, true, true>(lds, g, S, E, TIDP()); }
    }
    xcd_barrier(bar);
    {
    { pg8::Gemm g{XN, (const bf16*)(ws + WS_WIN) + (size_t)14 * 256 * 1024, MTOK, 2048, 1024}; pg8::StaticOrder S; S.init(MTOK, 2048, G, bid); EP.t0 = 14;
      pg8::gemm_phase<pg8::EpiProj, pg8::StaticOrder, true, true>(lds, g, S, EP, TIDP()); }
    }
    xcd_barrier(bar);
    {
    { pg8::Gemm g{(const bf16*)(ws + WS_MERGED), (const bf16*)(ws + WS_WOUT), MTOK, 1024, 1024}; pg8::StaticOrder S; S.init(MTOK, 1024, G, bid);
      pg8::EpiWout E{P.x, P.out, (bf16*)(ws + WS_X1B), (float*)(ws + WS_SSQP)};
      pg8::gemm_phase<pg8::EpiWout, pg8::StaticOrder, true, true>(lds, g, S, E, TIDP()); }
    }
    xcd_barrier(bar);
    { pg8::Gemm g{(const bf16*)(ws + WS_X1B), (const bf16*)(ws + WS_WGU), MTOK, 5632, 1024}; pg8::StaticOrder S; S.init(MTOK, 5632, G, bid);
      pg8::EpiGU E{(const float*)(ws + WS_SSQP), (bf16*)(ws + WS_HID)};
      pg8::gemm_phase<pg8::EpiGU, pg8::StaticOrder, true, true>(lds, g, S, E, TIDP()); }
    xcd_barrier(bar);
    { pg8::Gemm g{(const bf16*)(ws + WS_HID), (const bf16*)(ws + WS_WDN), MTOK, 1024, 2816}; pg8::StaticOrder S; S.init(MTOK, 1024, G, bid);
      pg8::EpiDown E{(const bf16*)(ws + WS_X1B), P.out};
      pg8::gemm_phase<pg8::EpiDown, pg8::StaticOrder, true, true>(lds, g, S, E, TIDP()); }
}

extern "C" void kernel_launch(void* const* d_in, const int* in_sizes, int n_in, void* d_out, int out_size, void* d_ws, size_t ws_size, hipStream_t stream) {
    static int grid = 0;
    if (grid == 0) {
        if (n_in != 18 || ws_size < WS_END) { fprintf(stderr, "kernel_launch: unexpected n_in %d / ws_size %zu (need %zu)\n", n_in, ws_size, (size_t)WS_END); grid = -1; return; }
        int dev = 0, cus = 0, per_cu = 0;
        hipGetDevice(&dev);
        hipDeviceGetAttribute(&cus, hipDeviceAttributeMultiprocessorCount, dev);
        if (hipFuncSetAttribute((const void*)fwd_kernel, hipFuncAttributeMaxDynamicSharedMemorySize, LDS_BYTES) != hipSuccess) fprintf(stderr, "kernel_launch: hipFuncSetAttribute failed\n");
        if (hipOccupancyMaxActiveBlocksPerMultiprocessor(&per_cu, (const void*)fwd_kernel, NTHR, LDS_BYTES) != hipSuccess || per_cu < 1) { fprintf(stderr, "kernel_launch: occupancy query gave %d\n", per_cu); per_cu = 1; }
        (void)hipGetLastError();
        grid = cus * per_cu;
    }
    if (grid < 0) return;
    Params p{};
    p.x = (const float*)d_in[0]; p.pos = (const int*)d_in[1]; p.g_mix = (const float*)d_in[2]; p.w_in = (const float*)d_in[3]; p.g_q_a = (const float*)d_in[4]; p.w_q_b = (const float*)d_in[5];
    p.g_kv_a = (const float*)d_in[6]; p.w_kv_b = (const float*)d_in[7]; p.g_qn = (const float*)d_in[8]; p.g_kn = (const float*)d_in[9]; p.w_mla_out = (const float*)d_in[10];
    p.dec_f = (const float*)d_in[11]; p.dec_b = (const float*)d_in[12]; p.w_ret_out = (const float*)d_in[13]; p.w_out = (const float*)d_in[14]; p.g_ffn = (const float*)d_in[15];
    p.w_gate_up = (const float*)d_in[16]; p.w_down = (const float*)d_in[17];
    p.out = (float*)d_out; p.ws = (unsigned char*)d_ws;
    if (hipMemsetAsync((unsigned char*)d_ws + WS_BAR, 0, 16384, stream) != hipSuccess) { fprintf(stderr, "kernel_launch: hipMemsetAsync failed\n"); return; }
    void* args[] = {&p};
    hipError_t e = hipLaunchCooperativeKernel((const void*)fwd_kernel, dim3(grid), dim3(NTHR), args, LDS_BYTES, stream);
    if (e != hipSuccess) fprintf(stderr, "kernel_launch: cooperative launch failed: %s (grid %d)\n", hipGetErrorString(e), grid);
}
```

```cpp
#include <hip/hip_runtime.h>
#include <hip/hip_cooperative_groups.h>
#include <cstdio>
#include <cstdint>
namespace cg = cooperative_groups;
#include <cstddef>
constexpr size_t MiB = 1u << 20;
constexpr size_t WS_WIN = 0, WS_WGU = 11 * MiB, WS_WDN = 22 * MiB, WS_WRET = 27 * MiB + 512 * 1024, WS_WOUT = 29 * MiB + 512 * 1024, WS_WMLA = 31 * MiB + 512 * 1024,
                 WS_WQB = 32 * MiB + 512 * 1024, WS_WKVB = 33 * MiB;
constexpr size_t WS_COSR = 34 * MiB, WS_SINR = 36 * MiB, WS_COSA = 38 * MiB, WS_SINA = 39 * MiB, WS_SSQP = 40 * MiB;
constexpr size_t WS_XN = 41 * MiB;
constexpr size_t WS_CQ = 73 * MiB, WS_CKV = 81 * MiB, WS_KROPE = 85 * MiB, WS_UQ = 86 * MiB, WS_UKV = 110 * MiB, WS_AQ = 142 * MiB, WS_AK = 166 * MiB, WS_AV = 190 * MiB, WS_AO = 206 * MiB;
constexpr size_t WS_RQ = 73 * MiB, WS_RK = 89 * MiB, WS_VR = 105 * MiB, WS_GR = 222 * MiB, WS_LT = 169 * MiB, WS_OB = 137 * MiB;
constexpr size_t WS_YB = 73 * MiB, WS_YA = 169 * MiB, WS_MERGED = 222 * MiB, WS_X1B = 73 * MiB, WS_HID = 105 * MiB;
constexpr int VT_PITCH = 16384 + 64;
constexpr size_t WS_RSTD = 254 * MiB + 16384;
constexpr size_t WS_BAR = 254 * MiB;
constexpr size_t WS_END = 254 * MiB + 16384 + 65536;

namespace pg8 {
#define PG8_LAS __attribute__((address_space(3)))
typedef unsigned short bf16_t;
typedef short bf16x8 __attribute__((ext_vector_type(8)));
typedef float f32x4 __attribute__((ext_vector_type(4)));
typedef unsigned u32x4 __attribute__((ext_vector_type(4)));
constexpr int BM = 256, BK = 64, HALF = 128, HTB = HALF * BK * 2  , STAGE_BYTES = 8 * HTB, NXCD = 8, WGM = 4;

__host__ __device__ __forceinline__ int lds_byte(int r, int c) { const int st = (r >> 4) * 2 + (c >> 5), rr = r & 15, cc = c & 31, ob = rr * 64 + cc * 2; return st * 1024 + (ob ^ (((ob >> 9) & 1) << 5)); }
__host__ __device__ __forceinline__ void stage_rc(int b, int& R, int& C) { const int st = b / 1024, sb = b % 1024, swz = sb ^ (((sb >> 9) & 1) << 5); R = (st >> 1) * 16 + swz / 64; C = (st & 1) * 32 + (swz % 64) / 2; }
__host__ __device__ __forceinline__ int perm32(int rho) { const int n = rho >> 4, i = rho & 15; return 8 * (i >> 2) + 4 * n + (i & 3); }

struct Unit { int pm, pn; };
struct Gemm { const bf16_t* A; const bf16_t* Bt; int M, N, K; };

struct StaticOrder {
    int nM, nN, nwg, G, c;
    __host__ __device__ void init(int M, int N, int G_, int c_) { nM = M / BM; nN = N / BM; nwg = nM * nN; G = G_; c = c_; }
    __host__ __device__ bool next(int i, Unit& u) const {
        const long L = (long)i * G + c; if (L >= nwg) return false;
        int wgid = (int)L; { const int q = nwg / NXCD, r = nwg % NXCD, xcd = wgid % NXCD, off = wgid / NXCD; wgid = (xcd < r ? xcd * (q + 1) : r * (q + 1) + (xcd - r) * q) + off; }
        const int nig = WGM * nN, gid = wgid / nig, fm = gid * WGM, gsz = (nM - fm) < WGM ? (nM - fm) : WGM;
        u.pm = fm + ((wgid % nig) % gsz); u.pn = (wgid % nig) / gsz; return true;
    }
    __device__ __forceinline__ void a_ready(const Unit&) const {}
    __device__ __forceinline__ void done(const Unit&) const {}
};

__device__ __forceinline__ unsigned cvt_pk_bf16(float lo, float hi) { unsigned r; asm volatile("v_cvt_pk_bf16_f32 %0, %1, %2" : "=v"(r) : "v"(lo), "v"(hi)); return r; }
typedef float f32x2 __attribute__((ext_vector_type(2)));
typedef unsigned u32x2 __attribute__((ext_vector_type(2)));
typedef float f32x2 __attribute__((ext_vector_type(2)));
typedef __bf16 bf16x2_t __attribute__((ext_vector_type(2)));
__device__ __forceinline__ unsigned pkbf(float lo, float hi) { f32x2 v = {lo, hi}; bf16x2_t b = __builtin_convertvector(v, bf16x2_t); return __builtin_bit_cast(unsigned, b); }
__device__ __forceinline__ float bf_lo(unsigned w) { return __uint_as_float(w << 16); }
__device__ __forceinline__ float bf_hi(unsigned w) { return __uint_as_float(w & 0xffff0000u); }
__device__ __forceinline__ float sigm(float x) { return __builtin_amdgcn_rcpf(1.f + __expf(-x)); }
__device__ __forceinline__ u32x4 pk8(const f32x4 a, const f32x4 b) { u32x4 w; w.x = pkbf(a[0], a[1]); w.y = pkbf(a[2], a[3]); w.z = pkbf(b[0], b[1]); w.w = pkbf(b[2], b[3]); return w; }

template <int X> __device__ __forceinline__ float shx(float v) { return __int_as_float(__builtin_amdgcn_ds_swizzle(__float_as_int(v), (X << 10) | 0x1f)); }
__device__ __forceinline__ float add_x32(float v) { auto rr = __builtin_amdgcn_permlane32_swap(__float_as_uint(v), __float_as_uint(v), false, false); return __uint_as_float(rr[0]) + __uint_as_float(rr[1]); }
__device__ __forceinline__ float max_x32(float v) { auto rr = __builtin_amdgcn_permlane32_swap(__float_as_uint(v), __float_as_uint(v), false, false); return fmaxf(__uint_as_float(rr[0]), __uint_as_float(rr[1])); }

struct EpiProj {
    static constexpr bool PERM = true, AFTER_DRAIN = false;
    int t0; unsigned char* ws;
    __device__ __forceinline__ void operator()(const f32x4 (&acc)[2][2][4][2], const Unit& u, int wr, int wc, int fr, int fq) const {
        const int t = t0 + u.pn;
        const int row0 = u.pm * BM + wr * 64 + fr;
        if (t >= 2 && t < 6) {
            const bool isk = t >= 4; bf16_t* O = (bf16_t*)(ws + (isk ? WS_RK : WS_RQ)); const float sc = isk ? 0.125f : 1.f;
            const float* cosR = (const float*)(ws + WS_COSR); const float* sinR = (const float*)(ws + WS_SINR);
            const int head = 4 * (t & 1) + wc, dl0 = 8 * fq;
#pragma unroll
            for (int ai = 0; ai < 2; ++ai)
#pragma unroll
              for (int mp = 0; mp < 2; ++mp) {
                f32x4 cc[2][2], sn_[2][2];
#pragma unroll
                for (int mm = 0; mm < 2; ++mm) { const size_t ro = (size_t)(row0 + ai * HALF + (2 * mp + mm) * 16) * 32 + dl0;
                    cc[mm][0] = *(const f32x4*)(cosR + ro); cc[mm][1] = *(const f32x4*)(cosR + ro + 4); sn_[mm][0] = *(const f32x4*)(sinR + ro); sn_[mm][1] = *(const f32x4*)(sinR + ro + 4); }
#pragma unroll
                for (int mm = 0; mm < 2; ++mm) {
                    const int m = 2 * mp + mm;
                    const int row = row0 + ai * HALF + m * 16;
                    const f32x4 c0 = cc[mm][0], c1 = cc[mm][1], s0 = sn_[mm][0], s1 = sn_[mm][1];
                    const f32x4 x1a = acc[ai][0][m][0], x1b = acc[ai][0][m][1], x2a = acc[ai][1][m][0], x2b = acc[ai][1][m][1];
                    const f32x4 o1a = (x1a * c0 - x2a * s0) * sc, o1b = (x1b * c1 - x2b * s1) * sc;
                    const f32x4 o2a = (x2a * c0 + x1a * s0) * sc, o2b = (x2b * c1 + x1b * s1) * sc;
                    bf16_t* p = O + (size_t)row * 512 + head * 64 + dl0;
                    *(u32x4*)p = pk8(o1a, o1b); *(u32x4*)(p + 32) = pk8(o2a, o2b);
                }
                asm volatile("" ::: "memory");
              }
        } else if (t >= 14) {
            const bf16_t* YA = (const bf16_t*)(ws + WS_YA); const bf16_t* YB = (const bf16_t*)(ws + WS_YB); bf16_t* MG = (bf16_t*)(ws + WS_MERGED);
            const int col = 128 * (t - 14) + 32 * wc + 8 * fq;
#pragma unroll
            for (int ai = 0; ai < 2; ++ai) {
                u32x4 yav[4], ybv[4];
#pragma unroll
                for (int m = 0; m < 4; ++m) { const size_t off = (size_t)(row0 + ai * HALF + m * 16) * 1024 + col; yav[m] = *(const u32x4*)(YA + off); ybv[m] = *(const u32x4*)(YB + off); }
#pragma unroll
                for (int m = 0; m < 4; ++m) {
                    const size_t off = (size_t)(row0 + ai * HALF + m * 16) * 1024 + col;
                    const u32x4 ya = yav[m], yb = ybv[m];
                    const f32x4 la0 = acc[ai][0][m][0], la1 = acc[ai][0][m][1], lb0 = acc[ai][1][m][0], lb1 = acc[ai][1][m][1];
                    f32x4 r0, r1;
                    r0[0] = sigm(la0[0]) * bf_lo(ya.x) + sigm(lb0[0]) * bf_lo(yb.x); r0[1] = sigm(la0[1]) * bf_hi(ya.x) + sigm(lb0[1]) * bf_hi(yb.x);
                    r0[2] = sigm(la0[2]) * bf_lo(ya.y) + sigm(lb0[2]) * bf_lo(yb.y); r0[3] = sigm(la0[3]) * bf_hi(ya.y) + sigm(lb0[3]) * bf_hi(yb.y);
                    r1[0] = sigm(la1[0]) * bf_lo(ya.z) + sigm(lb1[0]) * bf_lo(yb.z); r1[1] = sigm(la1[1]) * bf_hi(ya.z) + sigm(lb1[1]) * bf_hi(yb.z);
                    r1[2] = sigm(la1[2]) * bf_lo(ya.w) + sigm(lb1[2]) * bf_lo(yb.w); r1[3] = sigm(la1[3]) * bf_hi(ya.w) + sigm(lb1[3]) * bf_hi(yb.w);
                    *(u32x4*)(MG + off) = pk8(r0, r1);
                }
                asm volatile("" ::: "memory");
            }
        } else {
#pragma unroll
            for (int bj = 0; bj < 2; ++bj) {
                size_t wo; int ld, col; bool on = true;
                if (t == 0) { wo = WS_CQ; ld = 256; col = 128 * bj; }
                else if (t == 1) { if (bj == 0) { wo = WS_CKV; ld = 128; col = 0; } else { wo = WS_KROPE; ld = 32; col = 0; on = (wc == 0); } }
                else if (t < 10) { wo = WS_VR; ld = 1024; col = 256 * (t - 6) + 128 * bj; }
                else if (t < 14) { wo = WS_GR; ld = 1024; col = 256 * (t - 10) + 128 * bj; }
                else { wo = WS_GR; ld = 1024; col = 256 * ((t - 10) & 3) + 128 * bj; }
                bf16_t* O = (bf16_t*)(ws + wo);
                col += 32 * wc + 8 * fq;
                if (on) {
#pragma unroll
                    for (int ai = 0; ai < 2; ++ai)
#pragma unroll
                        for (int m = 0; m < 4; ++m) {
                            const int row = row0 + ai * HALF + m * 16;
                            *(u32x4*)(O + (size_t)row * ld + col) = pk8(acc[ai][bj][m][0], acc[ai][bj][m][1]);
                        }
                }
            }
        }
    }
};
struct EpiBf16S {
    static constexpr bool PERM = true, AFTER_DRAIN = false;
    bf16_t* O; int ldc;
    __device__ __forceinline__ void operator()(const f32x4 (&acc)[2][2][4][2], const Unit& u, int wr, int wc, int fr, int fq) const {
        const int row0 = u.pm * BM + wr * 64 + fr, col0 = u.pn * BM + 32 * wc + 8 * fq;
#pragma unroll
        for (int ai = 0; ai < 2; ++ai)
#pragma unroll
            for (int m = 0; m < 4; ++m)
#pragma unroll
                for (int bj = 0; bj < 2; ++bj)
                    *(u32x4*)(O + (size_t)(row0 + ai * HALF + m * 16) * ldc + col0 + bj * HALF) = pk8(acc[ai][bj][m][0], acc[ai][bj][m][1]);
    }
};
struct EpiGate {
    static constexpr bool PERM = true, AFTER_DRAIN = false;
    const bf16_t* GL; bf16_t* PART; bf16_t* MERGED; int second;
    __device__ __forceinline__ void operator()(const f32x4 (&acc)[2][2][4][2], const Unit& u, int wr, int wc, int fr, int fq) const {
        const int row0 = u.pm * BM + wr * 64 + fr, col0 = u.pn * BM + 32 * wc + 8 * fq;
#pragma unroll
        for (int ai = 0; ai < 2; ++ai)
#pragma unroll
            for (int m = 0; m < 4; ++m)
#pragma unroll
                for (int bj = 0; bj < 2; ++bj) {
                    const int row = row0 + ai * HALF + m * 16, col = col0 + bj * HALF;
                    const u32x4 g = *(const u32x4*)(GL + (size_t)row * 2048 + second * 1024 + col);
                    const f32x4 a = acc[ai][bj][m][0], b = acc[ai][bj][m][1];
                    f32x4 ra, rb;
                    ra[0] = sigm(bf_lo(g.x)) * a[0]; ra[1] = sigm(bf_hi(g.x)) * a[1]; ra[2] = sigm(bf_lo(g.y)) * a[2]; ra[3] = sigm(bf_hi(g.y)) * a[3];
                    rb[0] = sigm(bf_lo(g.z)) * b[0]; rb[1] = sigm(bf_hi(g.z)) * b[1]; rb[2] = sigm(bf_lo(g.w)) * b[2]; rb[3] = sigm(bf_hi(g.w)) * b[3];
                    if (second) {
                        const u32x4 p = *(const u32x4*)(PART + (size_t)row * 1024 + col);
                        ra[0] += bf_lo(p.x); ra[1] += bf_hi(p.x); ra[2] += bf_lo(p.y); ra[3] += bf_hi(p.y);
                        rb[0] += bf_lo(p.z); rb[1] += bf_hi(p.z); rb[2] += bf_lo(p.w); rb[3] += bf_hi(p.w);
                        *(u32x4*)(MERGED + (size_t)row * 1024 + col) = pk8(ra, rb);
                    } else {
                        *(u32x4*)(PART + (size_t)row * 1024 + col) = pk8(ra, rb);
                    }
                    asm volatile("" ::: "memory");
                }
    }
};
struct EpiWout {
    static constexpr bool PERM = false, AFTER_DRAIN = false;
    const float* X; float* X1; bf16_t* X1B; float* SSQP;
    __device__ __forceinline__ void operator()(const f32x4 (&acc)[2][2][4][2], const Unit& u, int wr, int wc, int fr, int fq) const {
        const int row0 = u.pm * BM + wr * 64 + fr, col0 = u.pn * BM + 32 * wc + 4 * fq;
#pragma unroll
        for (int ai = 0; ai < 2; ++ai)
#pragma unroll
            for (int mp = 0; mp < 2; ++mp) {
                f32x4 xv[2][2][2];
#pragma unroll
                for (int mm = 0; mm < 2; ++mm)
#pragma unroll
                    for (int bj = 0; bj < 2; ++bj)
#pragma unroll
                        for (int n = 0; n < 2; ++n) xv[mm][bj][n] = __builtin_nontemporal_load((const f32x4*)(X + (size_t)(row0 + ai * HALF + (2 * mp + mm) * 16) * 1024 + col0 + bj * HALF + n * 16));
#pragma unroll
                for (int mm = 0; mm < 2; ++mm) {
                    const int m = 2 * mp + mm, row = row0 + ai * HALF + m * 16; float ss = 0.f;
#pragma unroll
                    for (int bj = 0; bj < 2; ++bj)
#pragma unroll
                        for (int n = 0; n < 2; ++n) {
                            const size_t off = (size_t)row * 1024 + col0 + bj * HALF + n * 16;
                            const f32x4 o = xv[mm][bj][n] + acc[ai][bj][m][n];
                            u32x2 w; w.x = pkbf(o[0], o[1]); w.y = pkbf(o[2], o[3]); *(u32x2*)(X1B + off) = w;
                            ss += (o[0] * o[0] + o[1] * o[1]) + (o[2] * o[2] + o[3] * o[3]);
                        }
                    ss += shx<16>(ss); ss = add_x32(ss);
                    if (fq == 0) SSQP[(size_t)row * 16 + 4 * u.pn + wc] = ss;
                }
                asm volatile("" ::: "memory");
            }
    }
};
struct EpiGU {
    static constexpr bool PERM = true, AFTER_DRAIN = false;
    const float* SSQP; bf16_t* HID;
    __device__ __forceinline__ void operator()(const f32x4 (&acc)[2][2][4][2], const Unit& u, int wr, int wc, int fr, int fq) const {
        const int row0 = u.pm * BM + wr * 64 + fr, col0 = u.pn * HALF + 32 * wc + 8 * fq;
#pragma unroll
        for (int ai = 0; ai < 2; ++ai)
#pragma unroll
            for (int m = 0; m < 4; ++m) {
                const int row = row0 + ai * HALF + m * 16;
                const f32x4* sp = (const f32x4*)(SSQP + (size_t)row * 16);
                const f32x4 q0 = sp[0], q1 = sp[1], q2 = sp[2], q3 = sp[3];
                const f32x4 qs = (q0 + q1) + (q2 + q3);
                const float rstd = rsqrtf(((qs[0] + qs[1]) + (qs[2] + qs[3])) * (1.0f / 1024.0f) + 1e-6f);
                f32x4 h[2];
#pragma unroll
                for (int n = 0; n < 2; ++n)
#pragma unroll
                    for (int e = 0; e < 4; ++e) { const float g = acc[ai][0][m][n][e] * rstd, up = acc[ai][1][m][n][e] * rstd; h[n][e] = g * sigm(g) * up; }
                __builtin_nontemporal_store(pk8(h[0], h[1]), (u32x4*)(HID + (size_t)row * 2816 + col0));
                asm volatile("" ::: "memory");
            }
    }
};
struct EpiDown {
    static constexpr bool PERM = false, AFTER_DRAIN = false;
    const bf16_t* X1B; float* OUT;
    __device__ __forceinline__ void operator()(const f32x4 (&acc)[2][2][4][2], const Unit& u, int wr, int wc, int fr, int fq) const {
        const int row0 = u.pm * BM + wr * 64 + fr, col0 = u.pn * BM + 32 * wc + 4 * fq;
#pragma unroll
        for (int ai = 0; ai < 2; ++ai) {
            u32x2 xb[4][2][2];
#pragma unroll
            for (int m = 0; m < 4; ++m)
#pragma unroll
                for (int bj = 0; bj < 2; ++bj)
#pragma unroll
                    for (int n = 0; n < 2; ++n) xb[m][bj][n] = *(const u32x2*)(X1B + (size_t)(row0 + ai * HALF + m * 16) * 1024 + col0 + bj * HALF + n * 16);
#pragma unroll
            for (int m = 0; m < 4; ++m)
#pragma unroll
                for (int bj = 0; bj < 2; ++bj)
#pragma unroll
                    for (int n = 0; n < 2; ++n) {
                        const size_t off = (size_t)(row0 + ai * HALF + m * 16) * 1024 + col0 + bj * HALF + n * 16;
                        f32x4 xv; xv[0] = bf_lo(xb[m][bj][n].x); xv[1] = bf_hi(xb[m][bj][n].x); xv[2] = bf_lo(xb[m][bj][n].y); xv[3] = bf_hi(xb[m][bj][n].y);
                        __builtin_nontemporal_store(xv + acc[ai][bj][m][n], (f32x4*)(OUT + off));
                    }
            asm volatile("" ::: "memory");
        }
    }
};
template <class Epi, class Sched, bool ALIGN_EPI = false, bool SP2 = false>
__device__ __forceinline__ void gemm_phase(PG8_LAS unsigned char* lds, const Gemm g, const Sched& S, const Epi& E, int tid_in) {
    int tid_ = tid_in; asm volatile("" : "+v"(tid_));
    const int tid = tid_, wid = __builtin_amdgcn_readfirstlane(tid >> 6), lane = tid & 63, wr = wid >> 2, wc = wid & 3, fr = lane & 15, fq = lane >> 4;
    const int K = g.K, nt = K / BK;
    unsigned voffA[2], voffB[2];
#pragma unroll
    for (int i = 0; i < 2; ++i) { int R, C; stage_rc(tid * 16 + i * 8192, R, C); const int Rb = Epi::PERM ? ((R & ~31) + perm32(R & 31)) : R;
        voffA[i] = (unsigned)(R * K + C) * 2u; voffB[i] = (unsigned)(Rb * K + C) * 2u; }
    const size_t kstep = (size_t)(BK * 2);
    const size_t hstep = (size_t)HALF * K * 2;
    const size_t tstep = 2 * hstep;
    const unsigned ldsw = (unsigned)wid * 1024u;
    const int aoff = lds_byte(wr * 64 + fr, fq * 8), boff = lds_byte(wc * 32 + fr, fq * 8);
#define PG8_SA(b, h) (((b) * 2 + (h)) * HTB)
#define PG8_SB(b, h) ((4 + (b) * 2 + (h)) * HTB)
#define PG8_STAGE(bufoff, gbase, voff) do { _Pragma("unroll") for (int _i = 0; _i < 2; ++_i) \
        __builtin_amdgcn_global_load_lds((const unsigned*)((const char*)(gbase) + (voff)[_i]), (PG8_LAS unsigned*)(lds + (bufoff) + ldsw + _i * 8192), 16, 0, 0); } while (0)
#define PG8_LDA(dst, b, h) do { _Pragma("unroll") for (int m = 0; m < 4; ++m) _Pragma("unroll") for (int k = 0; k < 2; ++k) dst[m][k] = *(const PG8_LAS bf16x8*)(lds + PG8_SA(b, h) + aoff + m * 2048 + k * 1024); } while (0)
#define PG8_LDB(dst, b, h) do { _Pragma("unroll") for (int n = 0; n < 2; ++n) _Pragma("unroll") for (int k = 0; k < 2; ++k) dst[n][k] = *(const PG8_LAS bf16x8*)(lds + PG8_SB(b, h) + boff + n * 2048 + k * 1024); } while (0)
#define PG8_MMA(ai, bj, At, Bt) do { __builtin_amdgcn_s_setprio(1); _Pragma("unroll") for (int m = 0; m < 4; ++m) _Pragma("unroll") for (int n = 0; n < 2; ++n) _Pragma("unroll") for (int k = 0; k < 2; ++k) \
        acc[ai][bj][m][n] = __builtin_amdgcn_mfma_f32_16x16x32_bf16(Bt[n][k], At[m][k], acc[ai][bj][m][n], 0, 0, 0); __builtin_amdgcn_s_setprio(0); } while (0)
#define PG8_WAIT_V(n) asm volatile("s_waitcnt vmcnt(" #n ")" ::: "memory")
#define PG8_WAIT_L(n) asm volatile("s_waitcnt lgkmcnt(" #n ")" ::: "memory")
#define PG8_BAR __builtin_amdgcn_s_barrier()
#define PG8_SCHED __builtin_amdgcn_sched_barrier(0)
    Unit cur, nxt; int ui = 0;
    if (!S.next(0, cur)) return;
    f32x4 acc[2][2][4][2];
#pragma unroll
    for (int a = 0; a < 2; ++a)
#pragma unroll
        for (int b = 0; b < 2; ++b)
#pragma unroll
            for (int m = 0; m < 4; ++m)
#pragma unroll
                for (int n = 0; n < 2; ++n) acc[a][b][m][n] = (f32x4){0.f, 0.f, 0.f, 0.f};
    bf16x8 At[4][2], B0[2][2], B1[2][2];
    const char* cA = (const char*)g.A + (size_t)cur.pm * tstep; const char* cB = (const char*)g.Bt + (size_t)cur.pn * tstep;
    S.a_ready(cur);
    if constexpr (SP2) {
        PG8_STAGE(PG8_SB(0, 0), cB, voffB); PG8_STAGE(PG8_SB(0, 1), cB + hstep, voffB); PG8_STAGE(PG8_SA(0, 0), cA, voffA); PG8_STAGE(PG8_SA(0, 1), cA + hstep, voffA);
        if (wr == 1) PG8_BAR;
        PG8_WAIT_V(2); PG8_BAR;
        PG8_STAGE(PG8_SB(1, 0), cB + kstep, voffB); PG8_STAGE(PG8_SA(1, 0), cA + kstep, voffA); PG8_STAGE(PG8_SB(1, 1), cB + hstep + kstep, voffB);
        PG8_WAIT_V(6); PG8_BAR;
    } else {
        PG8_STAGE(PG8_SB(0, 0), cB, voffB); PG8_STAGE(PG8_SA(0, 0), cA, voffA); PG8_STAGE(PG8_SB(0, 1), cB + hstep, voffB); PG8_STAGE(PG8_SA(0, 1), cA + hstep, voffA);
        if (wr == 1) PG8_BAR;
        PG8_WAIT_V(4); PG8_BAR;
        PG8_STAGE(PG8_SB(1, 0), cB + kstep, voffB); PG8_STAGE(PG8_SA(1, 0), cA + kstep, voffA); PG8_STAGE(PG8_SB(1, 1), cB + hstep + kstep, voffB);
        PG8_WAIT_V(6); PG8_BAR;
    }
    for (;;) {
        const bool has_next = S.next(ui + 1, nxt);
        const char* nA = has_next ? (const char*)g.A + (size_t)nxt.pm * tstep : cA; const char* nB = has_next ? (const char*)g.Bt + (size_t)nxt.pn * tstep : cB;
        for (int t = 0; t < nt; t += 2) {
            const bool last = (t == nt - 2);
            const char* a1 = cA + (size_t)(t + 1) * kstep;
            const char* a2 = last ? nA : cA + (size_t)(t + 2) * kstep; const char* b2 = last ? nB : cB + (size_t)(t + 2) * kstep;
            const char* a3 = a2 + kstep; const char* b3 = b2 + kstep;
            if (last && has_next) S.a_ready(nxt);
            if constexpr (SP2) {
            PG8_LDB(B0, 0, 0); PG8_LDB(B1, 0, 1); PG8_SCHED; PG8_LDA(At, 0, 0); PG8_STAGE(PG8_SA(1, 1), a1 + hstep, voffA);
            PG8_WAIT_V(8); PG8_WAIT_L(0); PG8_BAR; PG8_MMA(0, 0, At, B0); PG8_MMA(0, 1, At, B1); PG8_BAR; PG8_SCHED;
            PG8_LDA(At, 0, 1); PG8_STAGE(PG8_SB(0, 0), b2, voffB); PG8_STAGE(PG8_SB(0, 1), b2 + hstep, voffB); PG8_STAGE(PG8_SA(0, 0), a2, voffA);
            PG8_WAIT_V(8); PG8_WAIT_L(0); PG8_BAR; PG8_MMA(1, 0, At, B0); PG8_MMA(1, 1, At, B1); PG8_BAR; PG8_SCHED;
            PG8_LDB(B0, 1, 0); PG8_LDB(B1, 1, 1); PG8_SCHED; PG8_LDA(At, 1, 0); PG8_STAGE(PG8_SA(0, 1), a2 + hstep, voffA);
            PG8_WAIT_V(8); PG8_WAIT_L(0); PG8_BAR; PG8_MMA(0, 0, At, B0); PG8_MMA(0, 1, At, B1); PG8_BAR; PG8_SCHED;
            PG8_LDA(At, 1, 1); PG8_STAGE(PG8_SB(1, 0), b3, voffB); PG8_STAGE(PG8_SB(1, 1), b3 + hstep, voffB); PG8_STAGE(PG8_SA(1, 0), a3, voffA);
            PG8_WAIT_V(8); PG8_WAIT_L(0); PG8_BAR; PG8_MMA(1, 0, At, B0); PG8_MMA(1, 1, At, B1); PG8_BAR; PG8_SCHED;
            } else {
            PG8_LDB(B0, 0, 0); PG8_SCHED; PG8_LDA(At, 0, 0); PG8_STAGE(PG8_SA(1, 1), a1 + hstep, voffA);
            PG8_WAIT_L(8); PG8_BAR; PG8_WAIT_L(0); PG8_MMA(0, 0, At, B0); PG8_BAR; PG8_SCHED;
            PG8_LDB(B1, 0, 1); PG8_STAGE(PG8_SB(0, 0), b2, voffB);
            PG8_BAR; PG8_WAIT_L(0); PG8_MMA(0, 1, At, B1); PG8_BAR;
            PG8_LDA(At, 0, 1); PG8_STAGE(PG8_SA(0, 0), a2, voffA);
            PG8_BAR; PG8_WAIT_L(0); PG8_MMA(1, 0, At, B0); PG8_BAR; PG8_SCHED;
            PG8_STAGE(PG8_SB(0, 1), b2 + hstep, voffB);
            PG8_WAIT_V(6); PG8_BAR; PG8_MMA(1, 1, At, B1); PG8_BAR;
            PG8_LDB(B0, 1, 0); PG8_SCHED; PG8_LDA(At, 1, 0); PG8_STAGE(PG8_SA(0, 1), a2 + hstep, voffA);
            PG8_WAIT_L(8); PG8_BAR; PG8_WAIT_L(0); PG8_MMA(0, 0, At, B0); PG8_BAR; PG8_SCHED;
            PG8_LDB(B1, 1, 1); PG8_STAGE(PG8_SB(1, 0), b3, voffB);
            PG8_BAR; PG8_WAIT_L(0); PG8_MMA(0, 1, At, B1); PG8_BAR;
            PG8_LDA(At, 1, 1); PG8_STAGE(PG8_SA(1, 0), a3, voffA);
            PG8_BAR; PG8_WAIT_L(0); PG8_MMA(1, 0, At, B0); PG8_BAR; PG8_SCHED;
            PG8_STAGE(PG8_SB(1, 1), b3 + hstep, voffB);
            PG8_WAIT_V(6); PG8_BAR; PG8_MMA(1, 1, At, B1); PG8_BAR;
            }
        }
        if constexpr (ALIGN_EPI) { if (wr == 0) PG8_BAR; }
        if constexpr (!Epi::AFTER_DRAIN) { E(acc, cur, wr, wc, fr, fq); S.done(cur); }
        if (!has_next) break;
#pragma unroll
        for (int a = 0; a < 2; ++a)
#pragma unroll
            for (int b = 0; b < 2; ++b)
#pragma unroll
                for (int m = 0; m < 4; ++m)
#pragma unroll
                    for (int n = 0; n < 2; ++n) acc[a][b][m][n] = (f32x4){0.f, 0.f, 0.f, 0.f};
        cur = nxt; cA = nA; cB = nB; ++ui;
        if constexpr (ALIGN_EPI) { if (wr == 1) PG8_BAR; }
    }
    PG8_WAIT_V(0);
    if constexpr (!ALIGN_EPI) { if (wr == 0) PG8_BAR; }
    PG8_BAR;
    if constexpr (Epi::AFTER_DRAIN) { E.fused(acc, cur, wr, wc, fr, fq, lds, wid, lane); S.done(cur); }
#undef PG8_SA
#undef PG8_SB
#undef PG8_STAGE
#undef PG8_LDA
#undef PG8_LDB
#undef PG8_MMA
#undef PG8_WAIT_V
#undef PG8_WAIT_L
#undef PG8_BAR
#undef PG8_SCHED
}
}
#define LAS __attribute__((address_space(3)))
typedef unsigned short bf16;
typedef unsigned u32x4 __attribute__((ext_vector_type(4)));
typedef unsigned u32x2 __attribute__((ext_vector_type(2)));
typedef float f32x4 __attribute__((ext_vector_type(4)));
typedef float f32x16 __attribute__((ext_vector_type(16)));
typedef short bf16x8 __attribute__((ext_vector_type(8)));
using pg8::pkbf; using pg8::bf_lo; using pg8::bf_hi; using pg8::shx; using pg8::add_x32; using pg8::max_x32;

constexpr int NWAVES = 8, NTHR = 512;
constexpr int MTOK = 16384, SEQL = 8192, DM = 1024;
constexpr float EPSF = 1e-6f, LOG2E = 1.4426950408889634f;
constexpr float QSCALE = 0.10206207261596577f * 1.4426950408889634f;
constexpr int LDS_BYTES = 131072 + 256;

struct Params {
    const float* x; const int* pos; const float *g_mix, *w_in, *g_q_a, *w_q_b, *g_kv_a, *w_kv_b, *g_qn, *g_kn, *w_mla_out, *dec_f, *dec_b, *w_ret_out, *w_out, *g_ffn, *w_gate_up, *w_down;
    float* out; unsigned char* ws;
};

__device__ __forceinline__ int crow(int r, int hi) { return (r & 3) + 8 * (r >> 2) + 4 * hi; }
__device__ __forceinline__ float ex2(float x) { return __builtin_amdgcn_exp2f(x); }
#define MFMA32(a, b, c) __builtin_amdgcn_mfma_f32_32x32x16_bf16((a), (b), (c), 0, 0, 0)
#define LDS_WAIT() asm volatile("s_waitcnt lgkmcnt(0)" ::: "memory")

__device__ __forceinline__ void cvt_item(const float* __restrict__ W, int N, bf16* WT, int K, int k0, int n0, int drow0, const float* gk, LAS float* scr, int lane) {
    float v[32];
#pragma unroll
    for (int i = 0; i < 32; ++i) { const int kk = 2 * i + (lane >> 5); v[i] = __builtin_nontemporal_load(W + (size_t)(k0 + kk) * N + n0 + (lane & 31)); }
#pragma unroll
    for (int i = 0; i < 32; ++i) { const int kk = 2 * i + (lane >> 5); float x = v[i]; if (gk) x *= gk[k0 + kk]; scr[kk * 33 + (lane & 31)] = x; }
    LDS_WAIT();
    const int c = lane & 7;
#pragma unroll
    for (int j = 0; j < 4; ++j) { const int n = (lane >> 3) + 8 * j; const LAS float* s = scr + (8 * c) * 33 + n;
        u32x4 o; o.x = pkbf(s[0 * 33], s[1 * 33]); o.y = pkbf(s[2 * 33], s[3 * 33]); o.z = pkbf(s[4 * 33], s[5 * 33]); o.w = pkbf(s[6 * 33], s[7 * 33]);
        *(u32x4*)(WT + (size_t)(drow0 + n) * K + k0 + 8 * c) = o; }
    LDS_WAIT();
}
__device__ __forceinline__ int win_row(int n0) {
    if (n0 < 256) return n0;
    if (n0 < 416) return 256 + (n0 - 256);
    if (n0 < 1440) { const int isk = n0 >= 928; const int j = n0 - (isk ? 928 : 416); const int head = j >> 6, d = j & 63;
        return (isk ? 1024 : 512) + 256 * (head >> 2) + 128 * (d >> 5) + 32 * (head & 3) + (d & 31); }
    if (n0 < 2464) return 1536 + (n0 - 1440);
    if (n0 < 3488) return 2560 + (n0 - 2464);
    { const int j = n0 - 3488, br = j >> 10, ch = j & 1023; return 3584 + 256 * (ch >> 7) + 128 * br + (ch & 127); }
}
__device__ __forceinline__ int wgu_row(int n0) { const int up = n0 >= 2816; const int j = n0 - (up ? 2816 : 0); return 256 * (j >> 7) + 128 * up + (j & 127); }
__device__ __forceinline__ float wave_sum(float v) {
    v += shx<1>(v); v += shx<2>(v); v += shx<4>(v); v += shx<8>(v); v += shx<16>(v);
    return add_x32(v);
}
__device__ __forceinline__ void p0_late_weights(const Params& P, LAS unsigned char* lds, int tid, int gw, int NGW) {
    const int lane = tid & 63, wave = tid >> 6;
    unsigned char* ws = P.ws;
    LAS float* scr = (LAS float*)(lds + wave * 16384);
    constexpr int I3 = 8 * 32, I4 = 16 * 32, I5 = 16 * 32, I6 = 16 * 176, I7 = 44 * 32;
    constexpr int NITEMS = I3 + I4 + I5 + I6 + I7;
    for (int it = gw; it < NITEMS; it += NGW) {
        int r = it;
        if (r < I3) { const int kb = r / 32, nb = r % 32; cvt_item(P.w_mla_out, 1024, (bf16*)(ws + WS_WMLA), 512, 64 * kb, 32 * nb, 32 * nb, nullptr, scr, lane); continue; } r -= I3;
        if (r < I4) { const int kb = r / 32, nb = r % 32; cvt_item(P.w_ret_out, 1024, (bf16*)(ws + WS_WRET), 1024, 64 * kb, 32 * nb, 32 * nb, nullptr, scr, lane); continue; } r -= I4;
        if (r < I5) { const int kb = r / 32, nb = r % 32; cvt_item(P.w_out, 1024, (bf16*)(ws + WS_WOUT), 1024, 64 * kb, 32 * nb, 32 * nb, nullptr, scr, lane); continue; } r -= I5;
        if (r < I6) { const int kb = r / 176, nb = r % 176; cvt_item(P.w_gate_up, 5632, (bf16*)(ws + WS_WGU), 1024, 64 * kb, 32 * nb, wgu_row(32 * nb), P.g_ffn, scr, lane); continue; } r -= I6;
        { const int kb = r / 32, nb = r % 32; cvt_item(P.w_down, 1024, (bf16*)(ws + WS_WDN), 2816, 64 * kb, 32 * nb, 32 * nb, nullptr, scr, lane); }
    }
}
__device__ __forceinline__ void p0_prologue(const Params& P, LAS unsigned char* lds, int tid, bool late_in_p0) {
    const int lane = tid & 63, wave = tid >> 6;
    unsigned char* ws = P.ws;
    LAS float* scr = (LAS float*)(lds + wave * 16384);
    const int gw = blockIdx.x * NWAVES + wave, NGW = gridDim.x * NWAVES;
    constexpr int I0 = 16 * 173, I1 = 4 * 24, I2 = 2 * 32;
    constexpr int NITEMS = I0 + I1 + I2;
    for (int it = gw; it < NITEMS; it += NGW) {
        int r = it;
        if (r < I0) { const int kb = r / 173, nb = r % 173; cvt_item(P.w_in, 5536, (bf16*)(ws + WS_WIN), 1024, 64 * kb, 32 * nb, win_row(32 * nb), nullptr, scr, lane); continue; } r -= I0;
        if (r < I1) { const int kb = r / 24, nb = r % 24; cvt_item(P.w_q_b, 768, (bf16*)(ws + WS_WQB), 256, 64 * kb, 32 * nb, 32 * nb, P.g_q_a, scr, lane); continue; } r -= I1;
        { const int kb = r / 32, nb = r % 32; cvt_item(P.w_kv_b, 1024, (bf16*)(ws + WS_WKVB), 128, 64 * kb, 32 * nb, 32 * nb, P.g_kv_a, scr, lane); }
    }
    if (late_in_p0) p0_late_weights(P, lds, tid, gw, NGW);
    const int gt = blockIdx.x * NTHR + tid, NGT = gridDim.x * NTHR;
    for (int i = gt; i < 12288; i += NGT) *((u32x4*)(ws + WS_WIN + (size_t)416 * 2048) + i) = (u32x4){0u, 0u, 0u, 0u};
    for (int i0 = gt; i0 < MTOK * 48; i0 += 8 * NGT) {
        int pv[8];
#pragma unroll
        for (int k = 0; k < 8; ++k) { const int i = i0 + k * NGT; const int tok = (i < MTOK * 32) ? (i >> 5) : ((i - MTOK * 32) >> 4); pv[k] = (i < MTOK * 48) ? P.pos[tok] : 0; }
#pragma unroll
        for (int k = 0; k < 8; ++k) {
            const int i = i0 + k * NGT;
            if (i < MTOK * 48) {
                int f; float inv; float *cd, *sd;
                if (i < MTOK * 32) { f = i & 31; inv = exp2f(-(float)f * (13.287712379549449f / 32.0f)); cd = (float*)(ws + WS_COSR) + i; sd = (float*)(ws + WS_SINR) + i; }
                else { const int k2 = i - MTOK * 32; f = k2 & 15; inv = exp2f(-(float)f * (13.287712379549449f / 16.0f)); cd = (float*)(ws + WS_COSA) + k2; sd = (float*)(ws + WS_SINA) + k2; }
                const float ang = (float)pv[k] * inv;
                double rev = (double)ang * 0.15915494309189535; rev -= rint(rev);
                const float fr = (float)rev;
                *cd = __builtin_amdgcn_cosf(fr); *sd = __builtin_amdgcn_sinf(fr);
            }
        }
    }
    bf16* XN = (bf16*)(ws + WS_XN);
    f32x4 gm[4];
#pragma unroll
    for (int j = 0; j < 4; ++j) gm[j] = *((const f32x4*)P.g_mix + lane + 64 * j);
    for (int m0 = 4 * gw; m0 < MTOK; m0 += 4 * NGW) {
        f32x4 v[4][4];
#pragma unroll
        for (int q = 0; q < 4; ++q)
#pragma unroll
            for (int j = 0; j < 4; ++j) v[q][j] = __builtin_nontemporal_load((const f32x4*)(P.x + (size_t)(m0 + q) * DM) + lane + 64 * j);
#pragma unroll
        for (int q = 0; q < 4; ++q) {
            float s = 0.f;
#pragma unroll
            for (int j = 0; j < 4; ++j) s += (v[q][j][0] * v[q][j][0] + v[q][j][1] * v[q][j][1]) + (v[q][j][2] * v[q][j][2] + v[q][j][3] * v[q][j][3]);
            const float rstd = rsqrtf(wave_sum(s) * (1.f / DM) + EPSF);
            u32x2* o8 = (u32x2*)(XN + (size_t)(m0 + q) * DM) + lane;
#pragma unroll
            for (int j = 0; j < 4; ++j) { u32x2 w; w.x = pkbf(v[q][j][0] * rstd * gm[j][0], v[q][j][1] * rstd * gm[j][1]); w.y = pkbf(v[q][j][2] * rstd * gm[j][2], v[q][j][3] * rstd * gm[j][3]); o8[64 * j] = w; }
        }
    }
}

__device__ __forceinline__ void unpack8(const u32x4 w, float (&f)[8]) {
#pragma unroll
    for (int i = 0; i < 4; ++i) { f[2 * i] = bf_lo(w[i]); f[2 * i + 1] = bf_hi(w[i]); }
}
__device__ __forceinline__ u32x4 pack8(const float (&f)[8]) { u32x4 o; o.x = pkbf(f[0], f[1]); o.y = pkbf(f[2], f[3]); o.z = pkbf(f[4], f[5]); o.w = pkbf(f[6], f[7]); return o; }
__device__ __forceinline__ float ssq8(const u32x4 w) { float s = 0.f;
#pragma unroll
    for (int i = 0; i < 4; ++i) { const float a = bf_lo(w[i]), b = bf_hi(w[i]); s += a * a + b * b; }
    return s; }
__device__ __forceinline__ void norm_rope_head(const u32x4* pa, float sa, const u32x4* pb, float sb, float s1, float s2, const float* __restrict__ gain, const float* cs, const float* sn, float oscale, u32x4* dst) {
    const float rn = rsqrtf((sa * sa * s1 + sb * sb * s2) * (1.f / 96.f) + EPSF) * oscale;
    const float fa = sa * rn, fb = sb * rn;
#pragma unroll 4
    for (int c = 0; c < 8; ++c) {
        float f[8]; unpack8(pa[c], f);
        const f32x4 g0 = *(const f32x4*)(gain + 8 * c), g1 = *(const f32x4*)(gain + 8 * c + 4);
#pragma unroll
        for (int i = 0; i < 4; ++i) { f[i] *= fa * g0[i]; f[4 + i] *= fa * g1[i]; }
        dst[c] = pack8(f);
    }
#pragma unroll
    for (int c = 0; c < 2; ++c) {
        float x1[8], x2[8]; unpack8(pb[c], x1); unpack8(pb[2 + c], x2);
        const f32x4 ga0 = *(const f32x4*)(gain + 64 + 8 * c), ga1 = *(const f32x4*)(gain + 68 + 8 * c), gb0 = *(const f32x4*)(gain + 80 + 8 * c), gb1 = *(const f32x4*)(gain + 84 + 8 * c);
        const f32x4 c0 = *(const f32x4*)(cs + 8 * c), c1 = *(const f32x4*)(cs + 8 * c + 4), n0 = *(const f32x4*)(sn + 8 * c), n1 = *(const f32x4*)(sn + 8 * c + 4);
        float o1[8], o2[8];
#pragma unroll
        for (int i = 0; i < 4; ++i) {
            const float a = x1[i] * fb * ga0[i], bq = x2[i] * fb * gb0[i]; o1[i] = a * c0[i] - bq * n0[i]; o2[i] = bq * c0[i] + a * n0[i];
            const float a2 = x1[4 + i] * fb * ga1[i], b2 = x2[4 + i] * fb * gb1[i]; o1[4 + i] = a2 * c1[i] - b2 * n1[i]; o2[4 + i] = b2 * c1[i] + a2 * n1[i];
        }
        dst[8 + c] = pack8(o1); dst[10 + c] = pack8(o2);
    }
}
__device__ __forceinline__ void norm_rope_head_r(const u32x4 (&w)[12], float sa, float sb, float s1, float s2, const float* __restrict__ gain, const float* cs, const float* sn, float oscale, u32x4* dst) {
    const float rn = rsqrtf((sa * sa * s1 + sb * sb * s2) * (1.f / 96.f) + EPSF) * oscale;
    const float fa = sa * rn, fb = sb * rn;
#pragma unroll
    for (int c = 0; c < 8; ++c) {
        float f[8]; unpack8(w[c], f);
        const f32x4 g0 = *(const f32x4*)(gain + 8 * c), g1 = *(const f32x4*)(gain + 8 * c + 4);
#pragma unroll
        for (int i = 0; i < 4; ++i) { f[i] *= fa * g0[i]; f[4 + i] *= fa * g1[i]; }
        dst[c] = pack8(f);
    }
#pragma unroll
    for (int c = 0; c < 2; ++c) {
        float x1[8], x2[8]; unpack8(w[8 + c], x1); unpack8(w[10 + c], x2);
        const f32x4 ga0 = *(const f32x4*)(gain + 64 + 8 * c), ga1 = *(const f32x4*)(gain + 68 + 8 * c), gb0 = *(const f32x4*)(gain + 80 + 8 * c), gb1 = *(const f32x4*)(gain + 84 + 8 * c);
        const f32x4 c0 = *(const f32x4*)(cs + 8 * c), c1 = *(const f32x4*)(cs + 8 * c + 4), n0 = *(const f32x4*)(sn + 8 * c), n1 = *(const f32x4*)(sn + 8 * c + 4);
        float o1[8], o2[8];
#pragma unroll
        for (int i = 0; i < 4; ++i) {
            const float a = x1[i] * fb * ga0[i], bq = x2[i] * fb * gb0[i]; o1[i] = a * c0[i] - bq * n0[i]; o2[i] = bq * c0[i] + a * n0[i];
            const float a2 = x1[4 + i] * fb * ga1[i], b2 = x2[4 + i] * fb * gb1[i]; o1[4 + i] = a2 * c1[i] - b2 * n1[i]; o2[4 + i] = b2 * c1[i] + a2 * n1[i];
        }
        dst[8 + c] = pack8(o1); dst[10 + c] = pack8(o2);
    }
}
__device__ __forceinline__ void mla_prep(const Params& P, int tid) {
    unsigned char* ws = P.ws;
    const bf16* CQ = (const bf16*)(ws + WS_CQ); const bf16* CKV = (const bf16*)(ws + WS_CKV); const bf16* KROPE = (const bf16*)(ws + WS_KROPE);
    const bf16* UQ = (const bf16*)(ws + WS_UQ); const bf16* UKV = (const bf16*)(ws + WS_UKV);
    bf16* AQ = (bf16*)(ws + WS_AQ); bf16* AK = (bf16*)(ws + WS_AK); bf16* AV = (bf16*)(ws + WS_AV);
    const float* cosA = (const float*)(ws + WS_COSA); const float* sinA = (const float*)(ws + WS_SINA);
    for (int tile = blockIdx.x; tile < MTOK / 64; tile += gridDim.x) {
        const int tk = tid >> 3, hd = tid & 7, row = tile * 64 + tk, b = row >> 13, s = row & (SEQL - 1);
        const u32x4* pq = (const u32x4*)(UQ + (size_t)row * 768 + 96 * hd);
        const u32x4* pk = (const u32x4*)(UKV + (size_t)row * 1024 + 128 * hd);
        const u32x4* pr = (const u32x4*)(KROPE + (size_t)row * 32);
        const size_t orow = (size_t)(b * 8 + hd) * SEQL + s;
        const float* cs = cosA + (size_t)row * 16; const float* sn = sinA + (size_t)row * 16;
        float sq = 0.f, skv = 0.f, sq1 = 0.f, sq2 = 0.f, sk1 = 0.f, sk2 = 0.f;
        float rq, rkv;
        {
            u32x4 wq[4], wkv[2], wu[12];
            { const u32x4* p = (const u32x4*)(CQ + (size_t)row * 256 + 32 * hd);
#pragma unroll
              for (int c = 0; c < 4; ++c) wq[c] = p[c]; }
            { const u32x4* p = (const u32x4*)(CKV + (size_t)row * 128 + 16 * hd);
#pragma unroll
              for (int c = 0; c < 2; ++c) wkv[c] = p[c]; }
#pragma unroll
            for (int c = 0; c < 12; ++c) wu[c] = pq[c];
#pragma unroll
            for (int c = 0; c < 4; ++c) sq += ssq8(wq[c]);
#pragma unroll
            for (int c = 0; c < 2; ++c) skv += ssq8(wkv[c]);
#pragma unroll
            for (int c = 0; c < 8; ++c) sq1 += ssq8(wu[c]);
#pragma unroll
            for (int c = 8; c < 12; ++c) sq2 += ssq8(wu[c]);
            sq += shx<1>(sq); sq += shx<2>(sq); sq += shx<4>(sq);
            skv += shx<1>(skv); skv += shx<2>(skv); skv += shx<4>(skv);
            rq = rsqrtf(sq * (1.f / 256.f) + EPSF); rkv = rsqrtf(skv * (1.f / 128.f) + EPSF);
            norm_rope_head_r(wu, rq, rq, sq1, sq2, P.g_qn, cs, sn, QSCALE, (u32x4*)(AQ + orow * 96));
        }
        asm volatile("" ::: "memory");
        {
            u32x4 wk[12], wv[8];
#pragma unroll
            for (int c = 0; c < 8; ++c) { wk[c] = pk[c]; wv[c] = pk[8 + c]; }
#pragma unroll
            for (int c = 0; c < 4; ++c) wk[8 + c] = pr[c];
#pragma unroll
            for (int c = 0; c < 8; ++c) sk1 += ssq8(wk[c]);
#pragma unroll
            for (int c = 8; c < 12; ++c) sk2 += ssq8(wk[c]);
            norm_rope_head_r(wk, rkv, 1.f, sk1, sk2, P.g_kn, cs, sn, 1.f, (u32x4*)(AK + orow * 96));
            u32x4* qv = (u32x4*)(AV + orow * 64);
#pragma unroll
            for (int c = 0; c < 8; ++c) { float f[8]; unpack8(wv[c], f);
#pragma unroll
                for (int i = 0; i < 8; ++i) f[i] *= rkv;
                qv[c] = pack8(f); }
        }
    }
}

constexpr int KPITCH = 208, VPITCH = 144, KBUF = 64 * KPITCH, VBUF = 64 * VPITCH;
constexpr int AT_K0 = 0, AT_V0 = 3 * KBUF;
constexpr float ATT_THR = 16.0f;
__device__ __forceinline__ float max3f(float a, float b, float c) { float r; asm("v_max3_f32 %0, %1, %2, %3" : "=v"(r) : "v"(a), "v"(b), "v"(c)); return r; }
template <bool LATE, bool NOMAX>
__device__ __forceinline__ void attn_unit(LAS unsigned char* lds, const bf16* AQ, const bf16* AK, const bf16* AV, bf16* AO, int bh, int qb, int tid) {
    const int lane = tid & 63, wid = tid >> 6, r32 = lane & 31, hi = lane >> 5;
    constexpr int NT = SEQL / 64;
    const size_t rowQ = (size_t)bh * SEQL + qb * 256 + wid * 32 + r32;
    bf16x8 qf[6];
#pragma unroll
    for (int s = 0; s < 6; ++s) qf[s] = *(const bf16x8*)(AQ + rowQ * 96 + 16 * s + 8 * hi);
    const unsigned char* Kg = (const unsigned char*)(AK + (size_t)bh * SEQL * 96);
    const unsigned char* Vg = (const unsigned char*)(AV + (size_t)bh * SEQL * 64);
    const int t2 = tid & 255;
    unsigned koff[3];
#pragma unroll
    for (int j = 0; j < 3; ++j) { const int c = t2 + 256 * j; koff[j] = (c / 12) * KPITCH + (c % 12) * 16; }
    const int vkey = t2 & 63, vdch = t2 >> 6, k15 = vkey & 15;
    const int vpos = 16 * (vkey >> 4) + (k15 & 3) + 4 * ((k15 >> 3) & 1) + 8 * ((k15 >> 2) & 1);
    const unsigned voff = (8 * vdch) * VPITCH + vpos * 2, vgoff = vkey * 128 + vdch * 16;
    f32x16 o0, o1, S0, S1, zero16;
#pragma unroll
    for (int r = 0; r < 16; ++r) { o0[r] = 0.f; o1[r] = 0.f; zero16[r] = 0.f; }
    float m = 0.f, lsum = 0.f;
    u32x4 kr[3], vr[2];
    const int rot = 4 * qb;
#define AT_TT(t) (((t) + rot) & (NT - 1))
#define AT_LOADK(t) do { if (!LATE) { const unsigned char* kg_ = Kg + (size_t)AT_TT(t) * 12288 + t2 * 16; _Pragma("unroll") for (int j = 0; j < 3; ++j) kr[j] = *(const u32x4*)(kg_ + 4096 * j); } } while (0)
#define AT_LOADV(t) do { if (!LATE) { const unsigned char* vg_ = Vg + (size_t)AT_TT(t) * 8192 + vgoff; vr[0] = *(const u32x4*)vg_; vr[1] = *(const u32x4*)(vg_ + 64); } } while (0)
#define AT_WRITEK(slot) do { if (!LATE) { _Pragma("unroll") for (int j = 0; j < 3; ++j) *(LAS u32x4*)(lds + AT_K0 + (slot) * KBUF + koff[j]) = kr[j]; } } while (0)
#define AT_WRITEV(slot) do { if (!LATE) { _Pragma("unroll") for (int jv = 0; jv < 2; ++jv) { LAS unsigned char* vb_ = lds + AT_V0 + (slot) * VBUF + voff + jv * 32 * VPITCH; \
        _Pragma("unroll") for (int e = 0; e < 8; ++e) *(LAS unsigned short*)(vb_ + e * VPITCH) = (unsigned short)((e & 1) ? (vr[jv][e >> 1] >> 16) : (vr[jv][e >> 1] & 0xffffu)); } } } while (0)
#define AT_KLOAD(slot) do { const LAS unsigned char* kb_ = lds + AT_K0 + (slot) * KBUF + r32 * KPITCH + 16 * hi; \
        _Pragma("unroll") for (int s = 0; s < 6; ++s) { kf0[s] = *(const LAS bf16x8*)(kb_ + 32 * s); kf1[s] = *(const LAS bf16x8*)(kb_ + 32 * KPITCH + 32 * s); } } while (0)
#define AT_VLOAD(slot) do { const LAS unsigned char* vb_ = lds + AT_V0 + (slot) * VBUF + r32 * VPITCH + 16 * hi; \
        _Pragma("unroll") for (int ks = 0; ks < 4; ++ks) { vf0[ks] = *(const LAS bf16x8*)(vb_ + 32 * ks); vf1[ks] = *(const LAS bf16x8*)(vb_ + 32 * VPITCH + 32 * ks); } } while (0)
#define AT_QK() do { __builtin_amdgcn_s_setprio(1); \
        _Pragma("unroll") for (int s = 0; s < 6; ++s) { \
            if (s == 0) { S0 = MFMA32(kf0[0], qf[0], zero16); S1 = MFMA32(kf1[0], qf[0], zero16); } else { S0 = MFMA32(kf0[s], qf[s], S0); S1 = MFMA32(kf1[s], qf[s], S1); } } __builtin_amdgcn_s_setprio(0); } while (0)
    bf16x8 kf0[6], kf1[6], vf0[4], vf1[4];
    AT_LOADK(0); AT_LOADV(0); AT_WRITEK(0); AT_WRITEV(0); AT_LOADK(1); AT_WRITEK(1);
    __syncthreads();
    AT_KLOAD(0);
    if (LATE) AT_QK();
    int ks_cur = 0, ks_nxt = 1, ks_wr = 2;
    for (int kt = 0; kt < NT; ++kt) {
        const int vcur = kt & 1;
        if (LATE) { AT_VLOAD(vcur); if (kt + 1 < NT) AT_KLOAD(ks_nxt); }
        __builtin_amdgcn_sched_barrier(0);
        if (!LATE) { AT_QK(); if (kt + 2 < NT) AT_LOADK(kt + 2); if (kt + 1 < NT) AT_LOADV(kt + 1); AT_VLOAD(vcur); __builtin_amdgcn_sched_barrier(0); }
        if (!NOMAX) {
            if (__any(m != 0.f)) {
    #pragma unroll
                for (int r = 0; r < 16; ++r) { S0[r] -= m; S1[r] -= m; }
            }
            asm volatile("s_nop 15\n\ts_nop 15" : "+v"(S0), "+v"(S1));
            float mx;
            { float a_ = max3f(S0[0], S0[1], S1[0]), b_ = max3f(S0[2], S0[3], S1[1]); a_ = max3f(a_, S1[2], S1[3]);
    #pragma unroll
              for (int r = 4; r < 16; r += 4) { a_ = max3f(a_, S0[r], S0[r + 1]); b_ = max3f(b_, S0[r + 2], S0[r + 3]); a_ = max3f(a_, S1[r], S1[r + 1]); b_ = max3f(b_, S1[r + 2], S1[r + 3]); }
              mx = max3f(a_, b_, b_); }
            mx = max_x32(mx);
            if (__any(mx > ATT_THR) || (kt == 0 && __any(mx < -ATT_THR))) {
                const float dl = (mx > ATT_THR || kt == 0) ? mx : 0.f;
                const float al = ex2(-dl); m += dl;
    #pragma unroll
                for (int r = 0; r < 16; ++r) { o0[r] *= al; o1[r] *= al; S0[r] -= dl; S1[r] -= dl; }
                lsum *= al;
            }
        }
#pragma unroll
        for (int r = 0; r < 16; ++r) { S0[r] = ex2(S0[r]); S1[r] = ex2(S1[r]); }
#pragma unroll
        for (int r = 0; r < 16; ++r) { lsum += S0[r]; lsum += S1[r]; }
#pragma unroll
        for (int ks = 0; ks < 4; ++ks) {
            u32x4 pw;
            if (ks < 2) { pw.x = pkbf(S0[8 * ks], S0[8 * ks + 1]); pw.y = pkbf(S0[8 * ks + 2], S0[8 * ks + 3]); pw.z = pkbf(S0[8 * ks + 4], S0[8 * ks + 5]); pw.w = pkbf(S0[8 * ks + 6], S0[8 * ks + 7]); }
            else { const int k2 = ks - 2; pw.x = pkbf(S1[8 * k2], S1[8 * k2 + 1]); pw.y = pkbf(S1[8 * k2 + 2], S1[8 * k2 + 3]); pw.z = pkbf(S1[8 * k2 + 4], S1[8 * k2 + 5]); pw.w = pkbf(S1[8 * k2 + 6], S1[8 * k2 + 7]); }
            const bf16x8 pf = __builtin_bit_cast(bf16x8, pw);
            o0 = MFMA32(vf0[ks], pf, o0); o1 = MFMA32(vf1[ks], pf, o1);
        }
        if (LATE) { if (kt + 1 < NT) AT_QK(); }
        else { if (kt + 1 < NT) { AT_KLOAD(ks_nxt); __builtin_amdgcn_sched_barrier(0); } }
        if (kt + 2 < NT) AT_WRITEK(ks_wr);
        if (kt + 1 < NT) AT_WRITEV(vcur ^ 1);
        __syncthreads();
        { const int t_ = ks_cur; ks_cur = ks_nxt; ks_nxt = ks_wr; ks_wr = t_; }
    }
#undef AT_LOADK
#undef AT_TT
#undef AT_LOADV
#undef AT_WRITEK
#undef AT_WRITEV
#undef AT_QK
#undef AT_KLOAD
#undef AT_VLOAD
    const float il = 1.f / add_x32(lsum);
    const int b = bh >> 3, h = bh & 7;
    bf16* orow = AO + ((size_t)b * SEQL + qb * 256 + wid * 32 + r32) * 512 + h * 64 + 4 * hi;
#pragma unroll
    for (int g = 0; g < 4; ++g) {
        u32x2 w0, w1;
        w0.x = pkbf(o0[4 * g] * il, o0[4 * g + 1] * il); w0.y = pkbf(o0[4 * g + 2] * il, o0[4 * g + 3] * il);
        w1.x = pkbf(o1[4 * g] * il, o1[4 * g + 1] * il); w1.y = pkbf(o1[4 * g + 2] * il, o1[4 * g + 3] * il);
        *(u32x2*)(orow + 8 * g) = w0; *(u32x2*)(orow + 32 + 8 * g) = w1;
    }
}

__device__ __forceinline__ float lg2_of(const float* dec, int h) { return -expf(dec[h]) * LOG2E; }
__device__ __forceinline__ void ret_scan(const Params& P, int tid) {
    bf16* LT = (bf16*)(P.ws + WS_LT);
    const int gt = blockIdx.x * NTHR + tid, NGT = gridDim.x * NTHR;
    for (int e = gt; e < 2 * 16 * 8192; e += NGT) {
        const int dir = e >> 17, bh = (e >> 13) & 15, el = e & 8191, h = bh & 7;
        const float g = ex2(lg2_of(dir ? P.dec_b : P.dec_f, h) * 128.f);
        bf16* base = LT + (size_t)((dir * 16 + bh) * 64) * 8192 + el;
        float st = 0.f;
        for (int c8 = 0; c8 < 8; ++c8) {
            float L[8];
#pragma unroll
            for (int i = 0; i < 8; ++i) { const int c = dir ? 63 - (8 * c8 + i) : 8 * c8 + i; L[i] = __uint_as_float((unsigned)base[(size_t)c * 8192] << 16); }
#pragma unroll
            for (int i = 0; i < 8; ++i) { const int c = dir ? 63 - (8 * c8 + i) : 8 * c8 + i; base[(size_t)c * 8192] = (bf16)(pkbf(st, 0.f) & 0xffffu); st = st * g + L[i]; }
        }
    }
}
__device__ __forceinline__ void ret_local_lds(const Params& P, LAS unsigned char* lds, int tid) {
    constexpr int LK = 0, LKP = 144, LV = 128 * 144, LVP = 272;
    unsigned char* ws = P.ws;
    const bf16* RK = (const bf16*)(ws + WS_RK); const bf16* VR = (const bf16*)(ws + WS_VR); bf16* LT = (bf16*)(ws + WS_LT);
    const int lane = tid & 63, wid = tid >> 6, r32 = lane & 31, hi = lane >> 5, dvb = wid & 3, dkb = wid >> 2;
    const int kt0 = tid >> 3, kp0 = tid & 7;
    const int vtok = tid & 127, vp0 = tid >> 7, t15 = vtok & 15;
    const int vpos = 16 * (vtok >> 4) + (t15 & 3) + 4 * ((t15 >> 3) & 1) + 8 * ((t15 >> 2) & 1);
    u32x4 gk[2], gv[4];
#define RL_LOAD(item_) do { const int bh_ = (item_) >> 6, ch_ = (item_) & 63, b_ = bh_ >> 3, h_ = bh_ & 7; const size_t t0_ = (size_t)b_ * SEQL + ch_ * 128; \
        _Pragma("unroll") for (int j = 0; j < 2; ++j) gk[j] = *(const u32x4*)(RK + (t0_ + kt0 + 64 * j) * 512 + h_ * 64 + kp0 * 8); \
        _Pragma("unroll") for (int j = 0; j < 4; ++j) gv[j] = *(const u32x4*)(VR + (t0_ + vtok) * 1024 + h_ * 128 + (vp0 + 4 * j) * 8); } while (0)
#define RL_STORE() do { \
        _Pragma("unroll") for (int j = 0; j < 2; ++j) *(LAS u32x4*)(lds + LK + (kt0 + 64 * j) * LKP + kp0 * 16) = gk[j]; \
        _Pragma("unroll") for (int j = 0; j < 4; ++j) { LAS unsigned char* vb_ = lds + LV + (8 * (vp0 + 4 * j)) * LVP + vpos * 2; \
            _Pragma("unroll") for (int e = 0; e < 8; ++e) *(LAS unsigned short*)(vb_ + e * LVP) = (unsigned short)((e & 1) ? (gv[j][e >> 1] >> 16) : (gv[j][e >> 1] & 0xffffu)); } } while (0)
    int item = blockIdx.x;
    if (item < 1024) RL_LOAD(item);
    for (; item < 1024; item += gridDim.x) {
        const int bh = item >> 6, ch = item & 63, h = bh & 7;
        RL_STORE();
        __syncthreads();
        if (item + (int)gridDim.x < 1024) RL_LOAD(item + (int)gridDim.x);
        const float lgf = lg2_of(P.dec_f, h), lgb = lg2_of(P.dec_b, h);
        f32x16 accf, accb;
#pragma unroll
        for (int r = 0; r < 16; ++r) { accf[r] = 0.f; accb[r] = 0.f; }
        const LAS unsigned char* vb = lds + LV + (32 * dvb + r32) * LVP + 16 * hi; const LAS unsigned char* kb = lds + LK + (32 * dkb + r32) * 2;
#pragma unroll 2
        for (int s = 0; s < 8; ++s) {
            const bf16x8 af = *(const LAS bf16x8*)(vb + 32 * s);
            float kf[8], kq[8];
#pragma unroll
            for (int jj = 0; jj < 8; ++jj) {
                const int j = 16 * s + (jj & 3) + 8 * (jj >> 2) + 4 * hi;
                const float kv = __uint_as_float((unsigned)(*(const LAS unsigned short*)(kb + j * LKP)) << 16);
                kf[jj] = kv * ex2(lgf * (float)(127 - j)); kq[jj] = kv * ex2(lgb * (float)j);
            }
            u32x4 w0, w1;
            w0.x = pkbf(kf[0], kf[1]); w0.y = pkbf(kf[2], kf[3]); w0.z = pkbf(kf[4], kf[5]); w0.w = pkbf(kf[6], kf[7]);
            w1.x = pkbf(kq[0], kq[1]); w1.y = pkbf(kq[2], kq[3]); w1.z = pkbf(kq[4], kq[5]); w1.w = pkbf(kq[6], kq[7]);
            accf = MFMA32(af, __builtin_bit_cast(bf16x8, w0), accf); accb = MFMA32(af, __builtin_bit_cast(bf16x8, w1), accb);
        }
        bf16* opf = LT + ((size_t)((0 * 16 + bh) * 64 + ch) * 128 + 32 * dvb) * 64 + 32 * dkb + r32;
        bf16* opb = LT + ((size_t)((1 * 16 + bh) * 64 + ch) * 128 + 32 * dvb) * 64 + 32 * dkb + r32;
#pragma unroll
        for (int r = 0; r < 16; ++r) { const int dv = crow(r, hi); opf[(size_t)dv * 64] = (bf16)(pkbf(accf[r], 0.f) & 0xffffu); opb[(size_t)dv * 64] = (bf16)(pkbf(accb[r], 0.f) & 0xffffu); }
        __syncthreads();
    }
#undef RL_LOAD
#undef RL_STORE
}

constexpr int RO_KP = 144, RO_VP = 272, RO_SP = 144;
constexpr int RO_K = 0, RO_V = RO_K + 128 * RO_KP, RO_SF = RO_V + 128 * RO_VP, RO_SB = RO_SF + 128 * RO_SP, RO_X = RO_SB + 128 * RO_SP, RO_END = RO_X + 8 * 32 * 4;
__device__ __forceinline__ void ret_out_lds(const Params& P, LAS unsigned char* lds, int tid) {
    unsigned char* ws = P.ws;
    const bf16* RQ = (const bf16*)(ws + WS_RQ); const bf16* RK = (const bf16*)(ws + WS_RK); const bf16* VR = (const bf16*)(ws + WS_VR); const bf16* GR = (const bf16*)(ws + WS_GR);
    const bf16* ST = (const bf16*)(ws + WS_LT); bf16* OB = (bf16*)(ws + WS_OB);
    const int lane = tid & 63, wid = tid >> 6, r32 = lane & 31, hi = lane >> 5, ib = wid & 3, dvh = wid >> 2;
    const int kt0 = tid >> 3, kp0 = tid & 7;
    const int vtok = tid & 127, vp0 = tid >> 7, t15 = vtok & 15;
    const int vpos = 16 * (vtok >> 4) + (t15 & 3) + 4 * ((t15 >> 3) & 1) + 8 * ((t15 >> 2) & 1);
    u32x4 gk[2], gv[4], gf[2], gb[2];
#define RO_LOAD(item_) do { const int bh_ = (item_) >> 6, ch_ = (item_) & 63, b_ = bh_ >> 3, h_ = bh_ & 7; const size_t t0_ = (size_t)b_ * SEQL + ch_ * 128; \
        _Pragma("unroll") for (int j = 0; j < 2; ++j) gk[j] = *(const u32x4*)(RK + (t0_ + kt0 + 64 * j) * 512 + h_ * 64 + kp0 * 8); \
        _Pragma("unroll") for (int j = 0; j < 4; ++j) gv[j] = *(const u32x4*)(VR + (t0_ + vtok) * 1024 + h_ * 128 + (vp0 + 4 * j) * 8); \
        const bf16* sf_ = ST + (size_t)((0 * 16 + bh_) * 64 + ch_) * 8192; const bf16* sb_ = ST + (size_t)((1 * 16 + bh_) * 64 + ch_) * 8192; \
        _Pragma("unroll") for (int j = 0; j < 2; ++j) { gf[j] = *(const u32x4*)(sf_ + (kt0 + 64 * j) * 64 + kp0 * 8); gb[j] = *(const u32x4*)(sb_ + (kt0 + 64 * j) * 64 + kp0 * 8); } } while (0)
#define RO_STORE() do { \
        _Pragma("unroll") for (int j = 0; j < 2; ++j) { *(LAS u32x4*)(lds + RO_K + (kt0 + 64 * j) * RO_KP + kp0 * 16) = gk[j]; \
            *(LAS u32x4*)(lds + RO_SF + (kt0 + 64 * j) * RO_SP + kp0 * 16) = gf[j]; *(LAS u32x4*)(lds + RO_SB + (kt0 + 64 * j) * RO_SP + kp0 * 16) = gb[j]; } \
        _Pragma("unroll") for (int j = 0; j < 4; ++j) { LAS unsigned char* vb_ = lds + RO_V + (8 * (vp0 + 4 * j)) * RO_VP + vpos * 2; \
            _Pragma("unroll") for (int e = 0; e < 8; ++e) *(LAS unsigned short*)(vb_ + e * RO_VP) = (unsigned short)((e & 1) ? (gv[j][e >> 1] >> 16) : (gv[j][e >> 1] & 0xffffu)); } } while (0)
    int item = blockIdx.x;
    if (item < 1024) RO_LOAD(item);
    for (; item < 1024; item += gridDim.x) {
        const int bh = item >> 6, ch = item & 63, b = bh >> 3, h = bh & 7;
        const size_t tok0 = (size_t)b * SEQL + ch * 128;
        RO_STORE();
        __syncthreads();
        if (item + (int)gridDim.x < 1024) RO_LOAD(item + (int)gridDim.x);
        const int il = 32 * ib + r32;
        const float lgf = lg2_of(P.dec_f, h), lgb = lg2_of(P.dec_b, h);
        bf16x8 qf[4];
#pragma unroll
        for (int s = 0; s < 4; ++s) qf[s] = *(const bf16x8*)(RQ + (tok0 + il) * 512 + h * 64 + 16 * s + 8 * hi);
        f32x16 acc[2];
#pragma unroll
        for (int d = 0; d < 2; ++d)
#pragma unroll
            for (int r = 0; r < 16; ++r) acc[d][r] = 0.f;
        const LAS unsigned char* sfb = lds + RO_SF + (64 * dvh + r32) * RO_SP + 16 * hi; const LAS unsigned char* sbb = lds + RO_SB + (64 * dvh + r32) * RO_SP + 16 * hi;
#pragma unroll
        for (int d = 0; d < 2; ++d)
#pragma unroll
            for (int s = 0; s < 4; ++s) { const bf16x8 a = *(const LAS bf16x8*)(sfb + 32 * d * RO_SP + 32 * s); acc[d] = MFMA32(a, qf[s], acc[d]); }
        const float wb = ex2(lgb * (float)(128 - il)), ratio = ex2(lgf * (float)(il + 1) - lgb * (float)(128 - il));
#pragma unroll
        for (int d = 0; d < 2; ++d)
#pragma unroll
            for (int r = 0; r < 16; ++r) acc[d][r] *= ratio;
#pragma unroll
        for (int d = 0; d < 2; ++d)
#pragma unroll
            for (int s = 0; s < 4; ++s) { const bf16x8 a = *(const LAS bf16x8*)(sbb + 32 * d * RO_SP + 32 * s); acc[d] = MFMA32(a, qf[s], acc[d]); }
#pragma unroll
        for (int d = 0; d < 2; ++d)
#pragma unroll
            for (int r = 0; r < 16; ++r) acc[d][r] *= wb;
        const LAS unsigned char* kb = lds + RO_K + r32 * RO_KP + 16 * hi; const LAS unsigned char* vb = lds + RO_V + (64 * dvh + r32) * RO_VP + 16 * hi;
#pragma unroll 2
        for (int jb = 0; jb < 4; ++jb) {
            f32x16 st;
#pragma unroll
            for (int r = 0; r < 16; ++r) st[r] = 0.f;
#pragma unroll
            for (int s = 0; s < 4; ++s) { const bf16x8 a = *(const LAS bf16x8*)(kb + 32 * jb * RO_KP + 32 * s); st = MFMA32(a, qf[s], st); }
#pragma unroll
            for (int r = 0; r < 16; ++r) { const int df = il - (32 * jb + crow(r, hi)); st[r] *= (df >= 0) ? ex2(lgf * (float)df) : ex2(lgb * (float)(-df)); }
#pragma unroll
            for (int ks = 0; ks < 2; ++ks) {
                u32x4 pw; pw.x = pkbf(st[8 * ks], st[8 * ks + 1]); pw.y = pkbf(st[8 * ks + 2], st[8 * ks + 3]); pw.z = pkbf(st[8 * ks + 4], st[8 * ks + 5]); pw.w = pkbf(st[8 * ks + 6], st[8 * ks + 7]);
                const bf16x8 pf = __builtin_bit_cast(bf16x8, pw);
#pragma unroll
                for (int d = 0; d < 2; ++d) { const bf16x8 af = *(const LAS bf16x8*)(vb + 32 * d * RO_VP + (32 * jb + 16 * ks) * 2); acc[d] = MFMA32(af, pf, acc[d]); }
            }
        }
        float ss = 0.f;
#pragma unroll
        for (int d = 0; d < 2; ++d)
#pragma unroll
            for (int r = 0; r < 16; ++r) ss += acc[d][r] * acc[d][r];
        ss = add_x32(ss);
        LAS float* X = (LAS float*)(lds + RO_X);
        if (hi == 0) X[wid * 32 + r32] = ss;
        __syncthreads();
        ss += X[(wid ^ 4) * 32 + r32];
        const float rstd = rsqrtf(ss * (1.f / 128.f) + EPSF);
        const size_t obase = (tok0 + il) * 1024 + h * 128 + 64 * dvh + 4 * hi;
#pragma unroll
        for (int d = 0; d < 2; ++d)
#pragma unroll
            for (int g = 0; g < 4; ++g) {
                const u32x2 gw2 = *(const u32x2*)(GR + obase + 32 * d + 8 * g);
                const float g0 = bf_lo(gw2.x), g1 = bf_hi(gw2.x), g2 = bf_lo(gw2.y), g3 = bf_hi(gw2.y);
                u32x2 o;
                o.x = pkbf(g0 * pg8::sigm(g0) * acc[d][4 * g] * rstd, g1 * pg8::sigm(g1) * acc[d][4 * g + 1] * rstd);
                o.y = pkbf(g2 * pg8::sigm(g2) * acc[d][4 * g + 2] * rstd, g3 * pg8::sigm(g3) * acc[d][4 * g + 3] * rstd);
                *(u32x2*)(OB + obase + 32 * d + 8 * g) = o;
            }
        __syncthreads();
    }
#undef RO_LOAD
#undef RO_STORE
}

#define XB_TMO      128
#define XB_XCNT(j)  (256  + 64 * (j))
#define XB_XSUB(j)  (1280 + 64 * (j))
#define XB_XGEN(j)  (2304 + 64 * (j))
#define XB_TOP      3328
#define XB_TOPGEN   3392
#define XCD_BAR_WORDS 3456
#define XB_SPIN_CAP (1u << 18)

__device__ __forceinline__ unsigned xb_ld(unsigned* p)              { return __hip_atomic_load(p, __ATOMIC_RELAXED, __HIP_MEMORY_SCOPE_AGENT); }
__device__ __forceinline__ unsigned xb_add(unsigned* p, unsigned v) { return __hip_atomic_fetch_add(p, v, __ATOMIC_RELAXED, __HIP_MEMORY_SCOPE_AGENT); }
__device__ __forceinline__ unsigned xb_xcc_id() { return (unsigned)__builtin_amdgcn_s_getreg((3 << 11) | 20) & 0xFu; }
#define XB_SPIN(cond, bar) do { unsigned _sp = 0; while (cond) { __builtin_amdgcn_s_sleep(1); \
    if ((++_sp & 255u) == 0u) { if (xb_ld(&(bar)[XB_TMO])) break; if (_sp > XB_SPIN_CAP) { atomicAdd(&(bar)[XB_TMO], 1u); break; } } } } while (0)

struct XcdBarrier {
    unsigned* bar; unsigned x;
    volatile LAS unsigned* st;
};

__device__ __forceinline__ XcdBarrier xcd_barrier_post(unsigned* bar, volatile LAS unsigned* st) {
    XcdBarrier b; b.bar = bar; b.x = xb_xcc_id(); b.st = st;
    if (threadIdx.x == 0) (void)xb_add(&bar[XB_XCNT(b.x)], 1u);
    return b;
}
__device__ __forceinline__ void xcd_barrier_complete(unsigned* bar, unsigned x, unsigned& nloc, unsigned& nx) {
    const unsigned G = gridDim.x * gridDim.y * gridDim.z;
    unsigned sum, cnt, mine, sp = 0u;
    for (;;) {
        sum = 0u; cnt = 0u; mine = 0u;
#pragma unroll
        for (unsigned j = 0; j < 16; ++j) { const unsigned c = xb_ld(&bar[XB_XCNT(j)]); sum += c; cnt += (c > 0u) ? 1u : 0u; mine = (j == x) ? c : mine; }
        if (sum == G) break;
        __builtin_amdgcn_s_sleep(1);
        if ((++sp & 255u) == 0u) { if (xb_ld(&bar[XB_TMO])) break; if (sp > XB_SPIN_CAP) { atomicAdd(&bar[XB_TMO], 1u); break; } }
    }
    nloc = mine > 0u ? mine : 1u; nx = cnt > 0u ? cnt : 1u;
}

__device__ __forceinline__ void xcd_barrier(const XcdBarrier& b) {
    asm volatile("s_waitcnt vmcnt(0)" ::: "memory");
    __syncthreads();
    if (threadIdx.x == 0) {
        unsigned* bar = b.bar;
        __builtin_amdgcn_s_waitcnt(0);
        unsigned nloc = b.st[0], nx = b.st[1];
        if (nloc == 0u) { xcd_barrier_complete(bar, b.x, nloc, nx); b.st[0] = nloc; b.st[1] = nx; }
        const unsigned old = xb_add(&bar[XB_XSUB(b.x)], 1u);
        const unsigned gen = old / nloc;
        if (old + 1u == (gen + 1u) * nloc) {
            __builtin_amdgcn_fence(__ATOMIC_RELEASE, "agent");
            asm volatile("s_waitcnt vmcnt(0)" ::: "memory");
            const unsigned og = xb_add(&bar[XB_TOP], 1u);
            const unsigned tg = og / nx;
            if (og + 1u == (tg + 1u) * nx) xb_add(&bar[XB_TOPGEN], 1u);
            else XB_SPIN(xb_ld(&bar[XB_TOPGEN]) == tg, bar);
            __builtin_amdgcn_fence(__ATOMIC_ACQUIRE, "agent");
            xb_add(&bar[XB_XGEN(b.x)], 1u);
            asm volatile("s_waitcnt vmcnt(0)" ::: "memory");
        } else {
            XB_SPIN(xb_ld(&bar[XB_XGEN(b.x)]) == gen, bar);
            __builtin_amdgcn_fence(__ATOMIC_ACQUIRE, "agent");
            asm volatile("s_waitcnt vmcnt(0)" ::: "memory");
        }
    }
    __syncthreads();
}

__global__ void __launch_bounds__(NTHR, 2) fwd_kernel(Params P) {
    extern __shared__ __attribute__((aligned(16))) unsigned char lds_raw[];
    LAS unsigned char* lds = (LAS unsigned char*)lds_raw;
    cg::grid_group grid = cg::this_grid();
    const int G = gridDim.x, bid = blockIdx.x;
    volatile LAS unsigned* MISC = (volatile LAS unsigned*)(lds + 131072);
    unsigned* barw = (unsigned*)(P.ws + WS_BAR);
    if (threadIdx.x < 2) MISC[threadIdx.x] = 0u;
    __syncthreads();
    XcdBarrier bar = xcd_barrier_post(barw, MISC);
    if (P.ws == nullptr) grid.sync();
    const int wave_s = __builtin_amdgcn_readfirstlane((int)threadIdx.x >> 6);
#define TIDP() ({ int l_; asm volatile("v_mbcnt_lo_u32_b32 %0, -1, 0\n\tv_mbcnt_hi_u32_b32 %0, -1, %0" : "=v"(l_)); wave_s * 64 + l_; })
    unsigned char* ws = P.ws;
    bf16* XN = (bf16*)(ws + WS_XN);
    pg8::EpiProj EP; EP.t0 = 0; EP.ws = ws;

    p0_prologue(P, lds, TIDP(), G <= 128);
        xcd_barrier(bar);
    {
    { pg8::Gemm g{XN, (const bf16*)(ws + WS_WIN), MTOK, 512, 1024}; pg8::StaticOrder S; S.init(MTOK, 512, G, bid); EP.t0 = 0;
      pg8::gemm_phase<pg8::EpiProj, pg8::StaticOrder, true, true>(lds, g, S, EP, TIDP()); }
    if (G > 128 && bid >= 128) { const int t_ = TIDP(); p0_late_weights(P, lds, t_, (bid - 128) * NWAVES + (t_ >> 6), (G - 128) * NWAVES); }
    }
    xcd_barrier(bar);
    {
    { int Kq = 256; asm volatile("" : "+s"(Kq)); pg8::Gemm g{(const bf16*)(ws + WS_CQ), (const bf16*)(ws + WS_WQB), MTOK, 768, Kq}; pg8::StaticOrder S; S.init(MTOK, 768, G, bid); pg8::EpiBf16S E{(bf16*)(ws + WS_UQ), 768};
      pg8::gemm_phase<pg8::EpiBf16S, pg8::StaticOrder, true, true>(lds, g, S, E, TIDP()); }
    { int Kk = 128; asm volatile("" : "+s"(Kk)); pg8::Gemm g{(const bf16*)(ws + WS_CKV), (const bf16*)(ws + WS_WKVB), MTOK, 1024, Kk}; pg8::StaticOrder S; S.init(MTOK, 1024, G, bid); pg8::EpiBf16S E{(bf16*)(ws + WS_UKV), 1024};
      pg8::gemm_phase<pg8::EpiBf16S, pg8::StaticOrder, true, true>(lds, g, S, E, TIDP()); }
    }
    xcd_barrier(bar);
    mla_prep(P, TIDP());
    xcd_barrier(bar);
    bool nomax;
    { float gq = 0.f, gk = 0.f;
      for (int i = 0; i < 96; ++i) { gq = fmaxf(gq, fabsf(P.g_qn[i])); gk = fmaxf(gk, fabsf(P.g_kn[i])); }
      const float bound = 9.797958971f * LOG2E * gq * gk;
      nomax = __builtin_amdgcn_readfirstlane((bound < 100.f) ? 1 : 0) != 0; }
    for (int u = bid; u < 512; u += G) {
        const int bh = (u & 7) * 2 + (u >> 8), qb = (u >> 3) & 31;
        if (nomax) {
            if (wave_s < 4) attn_unit<false, true>(lds, (const bf16*)(ws + WS_AQ), (const bf16*)(ws + WS_AK), (const bf16*)(ws + WS_AV), (bf16*)(ws + WS_AO), bh, qb, TIDP());
            else attn_unit<true, true>(lds, (const bf16*)(ws + WS_AQ), (const bf16*)(ws + WS_AK), (const bf16*)(ws + WS_AV), (bf16*)(ws + WS_AO), bh, qb, TIDP());
        } else {
            if (wave_s < 4) attn_unit<false, false>(lds, (const bf16*)(ws + WS_AQ), (const bf16*)(ws + WS_AK), (const bf16*)(ws + WS_AV), (bf16*)(ws + WS_AO), bh, qb, TIDP());
            else attn_unit<true, false>(lds, (const bf16*)(ws + WS_AQ), (const bf16*)(ws + WS_AK), (const bf16*)(ws + WS_AV), (bf16*)(ws + WS_AO), bh, qb, TIDP());
        }
    }
    { pg8::Gemm g{XN, (const bf16*)(ws + WS_WIN) + (size_t)2 * 256 * 1024, MTOK, 3072, 1024}; pg8::StaticOrder S; S.init(MTOK, 3072, G, bid); EP.t0 = 2;
      pg8::gemm_phase<pg8::EpiProj, pg8::StaticOrder, true, true>(lds, g, S, EP, TIDP()); }
    xcd_barrier(bar);
    ret_local_lds(P, lds, TIDP());
    xcd_barrier(bar);
    ret_scan(P, TIDP());
    xcd_barrier(bar);
    ret_out_lds(P, lds, TIDP());
    xcd_barrier(bar);
    {
    { pg8::Gemm g{(const bf16*)(ws + WS_AO), (const bf16*)(ws + WS_WMLA), MTOK, 1024, 512}; pg8::StaticOrder S; S.init(MTOK, 1024, G, bid); pg8::EpiBf16S E{(bf16*)(ws + WS_YA), 1024};
      pg8::gemm_phase<pg8::EpiBf16S, pg8::StaticOrder, true, true>(lds, g, S, E, TIDP()); }
    { pg8::Gemm g{(const bf16*)(ws + WS_OB), (const bf16*)(ws + WS_WRET), MTOK, 1024, 1024}; pg8::StaticOrder S; S.init(MTOK, 1024, G, bid); pg8::EpiBf16S E{(bf16*)(ws + WS_YB), 1024};
      pg8::gemm_phase<pg8::EpiBf16S, pg8::StaticOrder, true, true>(lds, g, S, E, TIDP()); }
    }
    xcd_barrier(bar);
    {
    { pg8::Gemm g{XN, (const bf16*)(ws + WS_WIN) + (size_t)14 * 256 * 1024, MTOK, 2048, 1024}; pg8::StaticOrder S; S.init(MTOK, 2048, G, bid); EP.t0 = 14;
      pg8::gemm_phase<pg8::EpiProj, pg8::StaticOrder, true, true>(lds, g, S, EP, TIDP()); }
    }
    xcd_barrier(bar);
    {
    { pg8::Gemm g{(const bf16*)(ws + WS_MERGED), (const bf16*)(ws + WS_WOUT), MTOK, 1024, 1024}; pg8::StaticOrder S; S.init(MTOK, 1024, G, bid);
      pg8::EpiWout E{P.x, P.out, (bf16*)(ws + WS_X1B), (float*)(ws + WS_SSQP)};
      pg8::gemm_phase<pg8::EpiWout, pg8::StaticOrder, true, true>(lds, g, S, E, TIDP()); }
    }
    xcd_barrier(bar);
    { pg8::Gemm g{(const bf16*)(ws + WS_X1B), (const bf16*)(ws + WS_WGU), MTOK, 5632, 1024}; pg8::StaticOrder S; S.init(MTOK, 5632, G, bid);
      pg8::EpiGU E{(const float*)(ws + WS_SSQP), (bf16*)(ws + WS_HID)};
      pg8::gemm_phase<pg8::EpiGU, pg8::StaticOrder, true, true>(lds, g, S, E, TIDP()); }
    xcd_barrier(bar);
    { pg8::Gemm g{(const bf16*)(ws + WS_HID), (const bf16*)(ws + WS_WDN), MTOK, 1024, 2816}; pg8::StaticOrder S; S.init(MTOK, 1024, G, bid);
      pg8::EpiDown E{(const bf16*)(ws + WS_X1B), P.out};
      pg8::gemm_phase<pg8::EpiDown, pg8::StaticOrder, true, true>(lds, g, S, E, TIDP()); }
}

extern "C" void kernel_launch(void* const* d_in, const int* in_sizes, int n_in, void* d_out, int out_size, void* d_ws, size_t ws_size, hipStream_t stream) {
    static int grid = 0;
    if (grid == 0) {
        if (n_in != 18 || ws_size < WS_END) { fprintf(stderr, "kernel_launch: unexpected n_in %d / ws_size %zu (need %zu)\n", n_in, ws_size, (size_t)WS_END); grid = -1; return; }
        int dev = 0, cus = 0, per_cu = 0;
        hipGetDevice(&dev);
        hipDeviceGetAttribute(&cus, hipDeviceAttributeMultiprocessorCount, dev);
        if (hipFuncSetAttribute((const void*)fwd_kernel, hipFuncAttributeMaxDynamicSharedMemorySize, LDS_BYTES) != hipSuccess) fprintf(stderr, "kernel_launch: hipFuncSetAttribute failed\n");
        if (hipOccupancyMaxActiveBlocksPerMultiprocessor(&per_cu, (const void*)fwd_kernel, NTHR, LDS_BYTES) != hipSuccess || per_cu < 1) { fprintf(stderr, "kernel_launch: occupancy query gave %d\n", per_cu); per_cu = 1; }
        (void)hipGetLastError();
        grid = cus * per_cu;
    }
    if (grid < 0) return;
    Params p{};
    p.x = (const float*)d_in[0]; p.pos = (const int*)d_in[1]; p.g_mix = (const float*)d_in[2]; p.w_in = (const float*)d_in[3]; p.g_q_a = (const float*)d_in[4]; p.w_q_b = (const float*)d_in[5];
    p.g_kv_a = (const float*)d_in[6]; p.w_kv_b = (const float*)d_in[7]; p.g_qn = (const float*)d_in[8]; p.g_kn = (const float*)d_in[9]; p.w_mla_out = (const float*)d_in[10];
    p.dec_f = (const float*)d_in[11]; p.dec_b = (const float*)d_in[12]; p.w_ret_out = (const float*)d_in[13]; p.w_out = (const float*)d_in[14]; p.g_ffn = (const float*)d_in[15];
    p.w_gate_up = (const float*)d_in[16]; p.w_down = (const float*)d_in[17];
    p.out = (float*)d_out; p.ws = (unsigned char*)d_ws;
    if (hipMemsetAsync((unsigned char*)d_ws + WS_BAR, 0, 16384, stream) != hipSuccess) { fprintf(stderr, "kernel_launch: hipMemsetAsync failed\n"); return; }
    void* args[] = {&p};
    hipError_t e = hipLaunchCooperativeKernel((const void*)fwd_kernel, dim3(grid), dim3(NTHR), args, LDS_BYTES, stream);
    if (e != hipSuccess) fprintf(stderr, "kernel_launch: cooperative launch failed: %s (grid %d)\n", hipGetErrorString(e), grid);
}
```
